# Optimizing an MI355X kernel written in HIP

```python
import jax, jax.numpy as jnp
from jax import lax
import numpy as np

D_MODEL = 1024
BATCH = 4
SEQ = 4096
DEPTH = 1

CHUNK = 64
PLE_DIM = 256
D_FF = 2816
MIX_WIDTH = D_MODEL
GLA_HEADS = 4
GLA_WIDTH = MIX_WIDTH // 2
GLA_DV = GLA_WIDTH // GLA_HEADS
GLA_DK = GLA_DV // 2
GLA_QK = GLA_HEADS * GLA_DK
GLA_GATE_RANK = 16
GLA_GATE_NORM = 16.0
RET_HEADS = 4
RET_WIDTH = MIX_WIDTH - GLA_WIDTH
RET_DV = RET_WIDTH // RET_HEADS
RET_DK = RET_DV // 2
RET_QK = RET_HEADS * RET_DK
ROPE_BASE = 10000.0
EPS = 1e-6
IN_COLS = 2 * GLA_QK + 2 * GLA_WIDTH + GLA_GATE_RANK + 2 * RET_QK + 2 * RET_WIDTH

kernel_name = "hymba_gla_retnet_macaron_ple"


def rms_norm(x, g):
    xf = x.astype(jnp.float32)
    y = xf * lax.rsqrt(jnp.mean(xf * xf, axis=-1, keepdims=True) + EPS)
    return (y * g.astype(jnp.float32)).astype(x.dtype)


def swiglu(x, w_gate, w_up, w_down):
    return (jax.nn.silu(x @ w_gate) * (x @ w_up)) @ w_down


def to_chunks(t, heads, dim):
    b, s, _ = t.shape
    return t.reshape(b, s // CHUNK, CHUNK, heads, dim).transpose(0, 3, 1, 2, 4)


def from_chunks(t):
    b, h, nc, c, d = t.shape
    return t.transpose(0, 2, 3, 1, 4).reshape(b, nc * c, h, d)


def chunk_state_scan(local_state, chunk_decay):
    def step(state, inp):
        u, a = inp
        return a * state + u, state
    xs = (jnp.moveaxis(local_state, 2, 0), jnp.moveaxis(chunk_decay, 2, 0))
    _, prev = lax.scan(step, jnp.zeros_like(local_state[:, :, 0]), xs)
    return jnp.moveaxis(prev, 0, 2)


def rope(t, heads, dim):
    b, s, _ = t.shape
    half = dim // 2
    inv = ROPE_BASE ** (-jnp.arange(half, dtype=jnp.float32) / half)
    ang = jnp.arange(s, dtype=jnp.float32)[:, None] * inv[None, :]
    cos = jnp.cos(ang)[None, :, None, :].astype(t.dtype)
    sin = jnp.sin(ang)[None, :, None, :].astype(t.dtype)
    th = t.reshape(b, s, heads, dim)
    t1, t2 = th[..., :half], th[..., half:]
    out = jnp.concatenate([t1 * cos - t2 * sin, t2 * cos + t1 * sin], axis=-1)
    return out.reshape(b, s, heads * dim)


def gla_mixer(q, k, v, r, gate_lr, w_gate_up, b_gate, g_norm):
    dt = q.dtype
    b_, s_, _ = q.shape
    logit = gate_lr @ w_gate_up + b_gate
    log_a = jax.nn.log_sigmoid(logit.astype(jnp.float32)) / GLA_GATE_NORM
    cum = jnp.cumsum(to_chunks(log_a, GLA_HEADS, GLA_DK), axis=3)
    cum_last = cum[:, :, :, -1:, :]
    qc = to_chunks(q, GLA_HEADS, GLA_DK) * (GLA_DK ** -0.5)
    kc = to_chunks(k, GLA_HEADS, GLA_DK)
    vc = to_chunks(v, GLA_HEADS, GLA_DV)
    e_pos = jnp.exp(cum).astype(dt)
    e_neg = jnp.exp(-cum).astype(dt)
    q_fwd = qc * e_pos
    idx = jnp.arange(CHUNK)
    causal = idx[:, None] >= idx[None, :]
    s_fwd = jnp.einsum('bhnid,bhnjd->bhnij', q_fwd, kc * e_neg)
    s_bwd = jnp.einsum('bhnid,bhnjd->bhnij', qc * e_neg, kc * e_pos)
    scores = jnp.where(causal, s_fwd, s_bwd)
    o_intra = jnp.einsum('bhnij,bhnjv->bhniv', scores, vc)
    k_state = kc * jnp.exp(cum_last - cum).astype(dt)
    local = jnp.einsum('bhnjd,bhnjv->bhndv', k_state, vc)
    decay = jnp.exp(cum_last[:, :, :, 0, :])[..., None].astype(dt)
    prev = chunk_state_scan(local, decay)
    o_inter = jnp.einsum('bhnid,bhndv->bhniv', q_fwd, prev)
    o = rms_norm(from_chunks(o_intra + o_inter), g_norm.reshape(GLA_HEADS, GLA_DV))
    return o.reshape(b_, s_, GLA_WIDTH) * jax.nn.silu(r)


def retention_mixer(q, k, v, g, g_norm):
    dt = q.dtype
    b_, s_, _ = q.shape
    log_gamma = jnp.log(1.0 - 2.0 ** (-5.0 - jnp.arange(RET_HEADS, dtype=jnp.float32)))
    qc = to_chunks(rope(q, RET_HEADS, RET_DK), RET_HEADS, RET_DK) * (RET_DK ** -0.5)
    kc = to_chunks(rope(k, RET_HEADS, RET_DK), RET_HEADS, RET_DK)
    vc = to_chunks(v, RET_HEADS, RET_DV)
    pos = jnp.arange(CHUNK, dtype=jnp.float32)
    dist = jnp.abs(pos[:, None] - pos[None, :])
    dmask = jnp.exp(log_gamma[:, None, None] * dist)[None, :, None].astype(dt)
    scores = jnp.einsum('bhnid,bhnjd->bhnij', qc, kc) * dmask
    o_intra = jnp.einsum('bhnij,bhnjv->bhniv', scores, vc)
    k_dec = jnp.exp(log_gamma[:, None] * (CHUNK - 1 - pos)[None, :])[None, :, None, :, None].astype(dt)
    local = jnp.einsum('bhnjd,bhnjv->bhndv', kc * k_dec, vc)
    decay = jnp.broadcast_to(jnp.exp(log_gamma * CHUNK)[None, :, None, None, None].astype(dt),
                             local.shape[:-1] + (1,))
    prev = chunk_state_scan(local, decay)
    q_dec = jnp.exp(log_gamma[:, None] * (pos + 1.0)[None, :])[None, :, None, :, None].astype(dt)
    o_inter = jnp.einsum('bhnid,bhndv->bhniv', qc * q_dec, prev)
    o = rms_norm(from_chunks(o_intra + o_inter), g_norm.reshape(RET_HEADS, RET_DV))
    return o.reshape(b_, s_, RET_WIDTH) * jax.nn.silu(g)


def setup_inputs(seed: int = 0) -> dict:
    key = jax.random.key(seed)
    ks = jax.random.split(key, 21)
    f32 = jnp.float32

    def w(k, shape, fan_in):
        return jax.random.normal(k, shape, f32) * (fan_in ** -0.5)

    def gain(k, shape):
        return 1.0 + 0.02 * jax.random.normal(k, shape, f32)

    L = DEPTH
    return {
        "x": jax.random.normal(ks[0], (BATCH, SEQ, D_MODEL), f32),
        "p": jax.random.normal(ks[1], (DEPTH, BATCH, SEQ, PLE_DIM), f32),
        "g_ffn1": gain(ks[2], (L, D_MODEL)),
        "w_ffn1_gate": w(ks[3], (L, D_MODEL, D_FF), D_MODEL),
        "w_ffn1_up": w(ks[4], (L, D_MODEL, D_FF), D_MODEL),
        "w_ffn1_down": w(ks[5], (L, D_FF, D_MODEL), D_FF),
        "g_mix": gain(ks[6], (L, D_MODEL)),
        "w_in": w(ks[7], (L, D_MODEL, IN_COLS), D_MODEL),
        "w_gla_gate_up": w(ks[8], (L, GLA_GATE_RANK, GLA_QK), GLA_GATE_RANK),
        "b_gla_gate": 0.1 * jax.random.normal(ks[9], (L, GLA_QK), f32),
        "g_gla_out": gain(ks[10], (L, GLA_WIDTH)),
        "g_ret_out": gain(ks[11], (L, RET_WIDTH)),
        "w_out": w(ks[12], (L, MIX_WIDTH, D_MODEL), MIX_WIDTH),
        "g_ffn2": gain(ks[13], (L, D_MODEL)),
        "w_ffn2_gate": w(ks[14], (L, D_MODEL, D_FF), D_MODEL),
        "w_ffn2_up": w(ks[15], (L, D_MODEL, D_FF), D_MODEL),
        "w_ffn2_down": w(ks[16], (L, D_FF, D_MODEL), D_FF),
        "g_ple": gain(ks[17], (L, D_MODEL)),
        "w_ple_gate": w(ks[18], (L, D_MODEL, D_MODEL), D_MODEL),
        "w_ple_proj": w(ks[19], (L, PLE_DIM, D_MODEL), PLE_DIM),
        "g_final": gain(ks[20], (D_MODEL,)),
    }


def reference(x, p, g_ffn1, w_ffn1_gate, w_ffn1_up, w_ffn1_down, g_mix, w_in, w_gla_gate_up,
              b_gla_gate, g_gla_out, g_ret_out, w_out, g_ffn2, w_ffn2_gate, w_ffn2_up, w_ffn2_down,
              g_ple, w_ple_gate, w_ple_proj, g_final):
    sizes = [GLA_QK, GLA_QK, GLA_WIDTH, GLA_WIDTH, GLA_GATE_RANK, RET_QK, RET_QK, RET_WIDTH, RET_WIDTH]
    offsets = [int(o) for o in np.cumsum(sizes)[:-1]]
    h = x
    for i in range(DEPTH):
        h = h + 0.5 * swiglu(rms_norm(h, g_ffn1[i]), w_ffn1_gate[i], w_ffn1_up[i], w_ffn1_down[i])
        z = rms_norm(h, g_mix[i]) @ w_in[i]
        gq, gk, gv, gr, glr, rq, rk, rv, rg = jnp.split(z, offsets, axis=-1)
        y_gla = gla_mixer(gq, gk, gv, gr, glr, w_gla_gate_up[i], b_gla_gate[i], g_gla_out[i])
        y_ret = retention_mixer(rq, rk, rv, rg, g_ret_out[i])
        h = h + jnp.concatenate([y_gla, y_ret], axis=-1) @ w_out[i]
        h = h + 0.5 * swiglu(rms_norm(h, g_ffn2[i]), w_ffn2_gate[i], w_ffn2_up[i], w_ffn2_down[i])
        gate = jax.nn.sigmoid(rms_norm(h, g_ple[i]) @ w_ple_gate[i])
        h = h + gate * (p[i] @ w_ple_proj[i])
    return rms_norm(h, g_final)
```

```cpp
#include <hip/hip_runtime.h>
#include <cstdio>
#include <cstdint>
namespace pg8 {
#define PG8_LAS __attribute__((address_space(3)))
typedef unsigned short bf16_t;
typedef short bf16x8 __attribute__((ext_vector_type(8)));
typedef float f32x4 __attribute__((ext_vector_type(4)));
typedef float f32x2 __attribute__((ext_vector_type(2)));
typedef unsigned u32x4 __attribute__((ext_vector_type(4)));
typedef unsigned u32x2 __attribute__((ext_vector_type(2)));
constexpr int BM = 256, BK = 64, HALF = 128, HTB = HALF * BK * 2  , STAGE_BYTES = 8 * HTB, NXCD = 8, WGM = 8;

__host__ __device__ __forceinline__ int lds_byte(int r, int c) { const int st = (r >> 4) * 2 + (c >> 5), rr = r & 15, cc = c & 31, ob = rr * 64 + cc * 2; return st * 1024 + (ob ^ (((ob >> 9) & 1) << 5)); }
__host__ __device__ __forceinline__ void stage_rc(int b, int& R, int& C) { const int st = b / 1024, sb = b % 1024, swz = sb ^ (((sb >> 9) & 1) << 5); R = (st >> 1) * 16 + swz / 64; C = (st & 1) * 32 + (swz % 64) / 2; }
__host__ __device__ __forceinline__ int perm32(int rho) { const int n = rho >> 4, i = rho & 15; return 8 * (i >> 2) + 4 * n + (i & 3); }

struct Unit { int pm, pn; };
struct Gemm { const bf16_t* A; const bf16_t* Bt; int M, N, K; };

struct StaticOrder {
    int nM, nN, nwg, G, c;
    __host__ __device__ void init(int M, int N, int G_, int c_) { nM = M / BM; nN = N / BM; nwg = nM * nN; G = G_; c = c_; }
    __host__ __device__ bool next(int i, Unit& u) const {
        const long L = (long)i * G + c; if (L >= nwg) return false;
        int wgid = (int)L; { const int q = nwg / NXCD, r = nwg % NXCD, xcd = wgid % NXCD, off = wgid / NXCD; wgid = (xcd < r ? xcd * (q + 1) : r * (q + 1) + (xcd - r) * q) + off; }
        const int nig = WGM * nN, gid = wgid / nig, fm = gid * WGM, gsz = (nM - fm) < WGM ? (nM - fm) : WGM;
        u.pm = fm + ((wgid % nig) % gsz); u.pn = (wgid % nig) / gsz; return true;
    }
    __device__ __forceinline__ void a_ready(const Unit&) const {}
    __device__ __forceinline__ void done(const Unit&) const {}
};

typedef __bf16 bf16x2v __attribute__((ext_vector_type(2)));
__device__ __forceinline__ unsigned cvt_pk_bf16(float lo, float hi) { f32x2 v = {lo, hi}; bf16x2v b = __builtin_convertvector(v, bf16x2v); return __builtin_bit_cast(unsigned, b); }
__device__ __forceinline__ float bf_lo(unsigned w) { return __uint_as_float(w << 16); }
__device__ __forceinline__ float bf_hi(unsigned w) { return __uint_as_float(w & 0xffff0000u); }
__device__ __forceinline__ float fast_sigmoid(float x) { return __builtin_amdgcn_rcpf(1.0f + __expf(-x)); }
constexpr float RMS_EPS = 1e-6f;
__device__ __forceinline__ float rstd_from_part(const float* part, int row) {
    const f32x4* p = (const f32x4*)(part + (size_t)row * 16);
    const f32x4 a = p[0], b = p[1], c = p[2], d = p[3];
    const float s = (((a[0] + a[1]) + (a[2] + a[3])) + ((b[0] + b[1]) + (b[2] + b[3]))) + (((c[0] + c[1]) + (c[2] + c[3])) + ((d[0] + d[1]) + (d[2] + d[3])));
    return 1.0f / sqrtf(s * (1.0f / 1024.0f) + RMS_EPS);
}

struct EpiSwiGLU {
    static constexpr bool PERM = true, AFTER_DRAIN = false;
    bf16_t* O; int ldc; const float* part;
    __device__ __forceinline__ void operator()(const f32x4 (&acc)[2][2][4][2], const Unit& u, int wr, int wc, int fr, int fq) const {
        const int row0 = u.pm * BM + wr * 64 + fr, col0 = u.pn * HALF + wc * 32 + 8 * fq;
#pragma unroll
        for (int ai = 0; ai < 2; ++ai)
#pragma unroll
            for (int m = 0; m < 4; ++m) { const int row = row0 + ai * HALF + m * 16; const float rs = rstd_from_part(part, row);
                float o[8];
#pragma unroll
                for (int n = 0; n < 2; ++n)
#pragma unroll
                    for (int e = 0; e < 4; ++e) { const float g = acc[ai][0][m][n][e] * rs, up = acc[ai][1][m][n][e] * rs; o[4 * n + e] = g * fast_sigmoid(g) * up; }
                u32x4 w; w.x = cvt_pk_bf16(o[0], o[1]); w.y = cvt_pk_bf16(o[2], o[3]); w.z = cvt_pk_bf16(o[4], o[5]); w.w = cvt_pk_bf16(o[6], o[7]);
                *(u32x4*)(O + (size_t)row * ldc + col0) = w; }
    }
};
struct EpiPlainBf16 {
    static constexpr bool PERM = true, AFTER_DRAIN = false;
    bf16_t* O; int ldc;
    __device__ __forceinline__ void operator()(const f32x4 (&acc)[2][2][4][2], const Unit& u, int wr, int wc, int fr, int fq) const {
        const int row0 = u.pm * BM + wr * 64 + fr, col0 = u.pn * BM + wc * 32 + 8 * fq;
#pragma unroll
        for (int ai = 0; ai < 2; ++ai)
#pragma unroll
            for (int m = 0; m < 4; ++m) { bf16_t* rowp = O + (size_t)(row0 + ai * HALF + m * 16) * ldc + col0;
#pragma unroll
                for (int bj = 0; bj < 2; ++bj) { const f32x4 v0 = acc[ai][bj][m][0], v1 = acc[ai][bj][m][1];
                    u32x4 w; w.x = cvt_pk_bf16(v0[0], v0[1]); w.y = cvt_pk_bf16(v0[2], v0[3]); w.z = cvt_pk_bf16(v1[0], v1[1]); w.w = cvt_pk_bf16(v1[2], v1[3]);
                    *(u32x4*)(rowp + bj * HALF) = w; } }
    }
};
struct EpiResid {
    static constexpr bool PERM = false, AFTER_DRAIN = false;
    const float* base; float* out; bf16_t* ob; float* part; float alpha; int ldc;
    __device__ __forceinline__ void operator()(const f32x4 (&acc)[2][2][4][2], const Unit& u, int wr, int wc, int fr, int fq) const {
        const int row0 = u.pm * BM + wr * 64 + fr, col0 = u.pn * BM + wc * 32 + 4 * fq;
#pragma unroll
        for (int ai = 0; ai < 2; ++ai)
#pragma unroll
            for (int m = 0; m < 4; ++m) { const int row = row0 + ai * HALF + m * 16; const size_t off = (size_t)row * ldc + col0; float ss = 0.f;
#pragma unroll
                for (int bj = 0; bj < 2; ++bj)
#pragma unroll
                    for (int n = 0; n < 2; ++n) { const size_t o2 = off + bj * HALF + n * 16; const f32x4 b = *(const f32x4*)(base + o2); const f32x4 v = b + acc[ai][bj][m][n] * alpha;
                        *(f32x4*)(out + o2) = v; u32x2 w; w.x = cvt_pk_bf16(v[0], v[1]); w.y = cvt_pk_bf16(v[2], v[3]); *(u32x2*)(ob + o2) = w;
                        ss += (v[0] * v[0] + v[1] * v[1]) + (v[2] * v[2] + v[3] * v[3]); }
                ss += __shfl_xor(ss, 16); ss += __shfl_xor(ss, 32);
                if (fq == 0) part[(size_t)row * 16 + u.pn * 4 + wc] = ss; }
    }
};
struct EpiPle {
    static constexpr bool PERM = false, AFTER_DRAIN = false;
    const float* base; float* out; const bf16_t* proj; const float* part_in; float* part_out; int ldc;
    __device__ __forceinline__ void operator()(const f32x4 (&acc)[2][2][4][2], const Unit& u, int wr, int wc, int fr, int fq) const {
        const int row0 = u.pm * BM + wr * 64 + fr, col0 = u.pn * BM + wc * 32 + 4 * fq;
#pragma unroll
        for (int ai = 0; ai < 2; ++ai)
#pragma unroll
            for (int m = 0; m < 4; ++m) { const int row = row0 + ai * HALF + m * 16; const size_t off = (size_t)row * ldc + col0; float ss = 0.f; const float rs = rstd_from_part(part_in, row);
#pragma unroll
                for (int bj = 0; bj < 2; ++bj)
#pragma unroll
                    for (int n = 0; n < 2; ++n) { const size_t o2 = off + bj * HALF + n * 16; const f32x4 b = *(const f32x4*)(base + o2); const u32x2 pw = *(const u32x2*)(proj + o2);
                        const f32x4 a = acc[ai][bj][m][n] * rs; f32x4 v;
                        v[0] = b[0] + fast_sigmoid(a[0]) * bf_lo(pw.x); v[1] = b[1] + fast_sigmoid(a[1]) * bf_hi(pw.x); v[2] = b[2] + fast_sigmoid(a[2]) * bf_lo(pw.y); v[3] = b[3] + fast_sigmoid(a[3]) * bf_hi(pw.y);
                        *(f32x4*)(out + o2) = v; ss += (v[0] * v[0] + v[1] * v[1]) + (v[2] * v[2] + v[3] * v[3]); }
                ss += __shfl_xor(ss, 16); ss += __shfl_xor(ss, 32);
                if (fq == 0) part_out[(size_t)row * 16 + u.pn * 4 + wc] = ss; }
    }
};
struct EpiZ {
    static constexpr bool PERM = true, AFTER_DRAIN = false;
    bf16_t* Z; float* GLR; const float* part; const float* COS; const float* SIN;
    __device__ __forceinline__ void operator()(const f32x4 (&acc)[2][2][4][2], const Unit& u, int wr, int wc, int fr, int fq) const {
        const int row0 = u.pm * BM + wr * 64 + fr, pn = u.pn;
        const bool is_rope = (pn == 6 || pn == 7), is_silu = (pn == 4 || pn == 5 || pn == 10 || pn == 11), is_glr = (pn == 12);
        const float sc = (pn == 0 || pn == 6) ? 0.125f : 1.0f;
#pragma unroll
        for (int ai = 0; ai < 2; ++ai)
#pragma unroll
            for (int m = 0; m < 4; ++m) { const int row = row0 + ai * HALF + m * 16; const float rs = rstd_from_part(part, row) * sc;
                if (is_glr) {
                    if (wc == 0 && fq < 2) { *(f32x4*)(GLR + (size_t)row * 16 + 8 * fq) = acc[ai][0][m][0] * rs; *(f32x4*)(GLR + (size_t)row * 16 + 8 * fq + 4) = acc[ai][0][m][1] * rs; }
                } else if (is_rope) {
                    const int pos = row & 4095; const float* cp = COS + pos * 32 + 8 * fq; const float* sp = SIN + pos * 32 + 8 * fq;
                    float o1[8], o2[8];
#pragma unroll
                    for (int n = 0; n < 2; ++n) { const f32x4 c = *(const f32x4*)(cp + 4 * n), s = *(const f32x4*)(sp + 4 * n);
#pragma unroll
                        for (int e = 0; e < 4; ++e) { const float t1 = acc[ai][0][m][n][e] * rs, t2 = acc[ai][1][m][n][e] * rs; o1[4 * n + e] = t1 * c[e] - t2 * s[e]; o2[4 * n + e] = t2 * c[e] + t1 * s[e]; } }
                    bf16_t* rowp = Z + (size_t)row * 3072 + pn * BM + wc * 64 + 8 * fq;
                    u32x4 w; w.x = cvt_pk_bf16(o1[0], o1[1]); w.y = cvt_pk_bf16(o1[2], o1[3]); w.z = cvt_pk_bf16(o1[4], o1[5]); w.w = cvt_pk_bf16(o1[6], o1[7]); *(u32x4*)rowp = w;
                    w.x = cvt_pk_bf16(o2[0], o2[1]); w.y = cvt_pk_bf16(o2[2], o2[3]); w.z = cvt_pk_bf16(o2[4], o2[5]); w.w = cvt_pk_bf16(o2[6], o2[7]); *(u32x4*)(rowp + 32) = w;
                } else {
                    bf16_t* rowp = Z + (size_t)row * 3072 + pn * BM + wc * 32 + 8 * fq;
#pragma unroll
                    for (int bj = 0; bj < 2; ++bj) { f32x4 v0 = acc[ai][bj][m][0] * rs, v1 = acc[ai][bj][m][1] * rs;
                        if (is_silu) {
#pragma unroll
                            for (int e = 0; e < 4; ++e) { v0[e] = v0[e] * fast_sigmoid(v0[e]); v1[e] = v1[e] * fast_sigmoid(v1[e]); } }
                        u32x4 w; w.x = cvt_pk_bf16(v0[0], v0[1]); w.y = cvt_pk_bf16(v0[2], v0[3]); w.z = cvt_pk_bf16(v1[0], v1[1]); w.w = cvt_pk_bf16(v1[2], v1[3]);
                        *(u32x4*)(rowp + bj * HALF) = w; }
                } }
    }
};
template <class Epi, class Sched, bool ALIGN_EPI = false, bool SP2 = false>
__device__ __forceinline__ void gemm_phase(PG8_LAS unsigned char* lds, const Gemm g, const Sched& S, const Epi& E, const int wave_id) {
    int tid_ = wave_id * 64 + (int)__builtin_amdgcn_mbcnt_hi(~0u, __builtin_amdgcn_mbcnt_lo(~0u, 0u)); asm volatile("" : "+v"(tid_));
    const int tid = tid_, wid = __builtin_amdgcn_readfirstlane(tid >> 6), lane = tid & 63, wr = wid >> 2, wc = wid & 3, fr = lane & 15, fq = lane >> 4;
    const int K = g.K, nt = K / BK;
    unsigned voffA[2], voffB[2];
#pragma unroll
    for (int i = 0; i < 2; ++i) { int R, C; stage_rc(tid * 16 + i * 8192, R, C); const int Rb = Epi::PERM ? ((R & ~31) + perm32(R & 31)) : R;
        voffA[i] = (unsigned)(R * K + C) * 2u; voffB[i] = (unsigned)(Rb * K + C) * 2u; }
    const size_t kstep = (size_t)(BK * 2);
    const size_t hstep = (size_t)HALF * K * 2;
    const size_t tstep = 2 * hstep;
    const unsigned ldsw = (unsigned)wid * 1024u;
    const int aoff = lds_byte(wr * 64 + fr, fq * 8), boff = lds_byte(wc * 32 + fr, fq * 8);
#define PG8_SA(b, h) (((b) * 2 + (h)) * HTB)
#define PG8_SB(b, h) ((4 + (b) * 2 + (h)) * HTB)
#define PG8_STAGE(bufoff, gbase, voff) do { _Pragma("unroll") for (int _i = 0; _i < 2; ++_i) \
        __builtin_amdgcn_global_load_lds((const unsigned*)((const char*)(gbase) + (voff)[_i]), (PG8_LAS unsigned*)(lds + (bufoff) + ldsw + _i * 8192), 16, 0, 0); } while (0)
#define PG8_LDA(dst, b, h) do { _Pragma("unroll") for (int m = 0; m < 4; ++m) _Pragma("unroll") for (int k = 0; k < 2; ++k) dst[m][k] = *(const PG8_LAS bf16x8*)(lds + PG8_SA(b, h) + aoff + m * 2048 + k * 1024); } while (0)
#define PG8_LDB(dst, b, h) do { _Pragma("unroll") for (int n = 0; n < 2; ++n) _Pragma("unroll") for (int k = 0; k < 2; ++k) dst[n][k] = *(const PG8_LAS bf16x8*)(lds + PG8_SB(b, h) + boff + n * 2048 + k * 1024); } while (0)
#define PG8_MMA(ai, bj, At, Bt) do { __builtin_amdgcn_s_setprio(1); _Pragma("unroll") for (int m = 0; m < 4; ++m) _Pragma("unroll") for (int n = 0; n < 2; ++n) _Pragma("unroll") for (int k = 0; k < 2; ++k) \
        acc[ai][bj][m][n] = __builtin_amdgcn_mfma_f32_16x16x32_bf16(Bt[n][k], At[m][k], acc[ai][bj][m][n], 0, 0, 0); __builtin_amdgcn_s_setprio(0); } while (0)
#define PG8_WAIT_V(n) asm volatile("s_waitcnt vmcnt(" #n ")" ::: "memory")
#define PG8_WAIT_L(n) asm volatile("s_waitcnt lgkmcnt(" #n ")" ::: "memory")
#define PG8_BAR __builtin_amdgcn_s_barrier()
#define PG8_SCHED __builtin_amdgcn_sched_barrier(0)
    Unit cur, nxt; int ui = 0;
    if (!S.next(0, cur)) return;
    f32x4 acc[2][2][4][2];
#pragma unroll
    for (int a = 0; a < 2; ++a)
#pragma unroll
        for (int b = 0; b < 2; ++b)
#pragma unroll
            for (int m = 0; m < 4; ++m)
#pragma unroll
                for (int n = 0; n < 2; ++n) acc[a][b][m][n] = (f32x4){0.f, 0.f, 0.f, 0.f};
    bf16x8 At[4][2], B0[2][2], B1[2][2];
    const char* cA = (const char*)g.A + (size_t)cur.pm * tstep; const char* cB = (const char*)g.Bt + (size_t)cur.pn * tstep;
    S.a_ready(cur);
    if constexpr (SP2) {
        PG8_STAGE(PG8_SB(0, 0), cB, voffB); PG8_STAGE(PG8_SB(0, 1), cB + hstep, voffB); PG8_STAGE(PG8_SA(0, 0), cA, voffA); PG8_STAGE(PG8_SA(0, 1), cA + hstep, voffA);
        if (wr == 1) PG8_BAR;
        PG8_WAIT_V(2); PG8_BAR;
        PG8_STAGE(PG8_SB(1, 0), cB + kstep, voffB); PG8_STAGE(PG8_SA(1, 0), cA + kstep, voffA); PG8_STAGE(PG8_SB(1, 1), cB + hstep + kstep, voffB);
        PG8_WAIT_V(6); PG8_BAR;
    } else {
        PG8_STAGE(PG8_SB(0, 0), cB, voffB); PG8_STAGE(PG8_SA(0, 0), cA, voffA); PG8_STAGE(PG8_SB(0, 1), cB + hstep, voffB); PG8_STAGE(PG8_SA(0, 1), cA + hstep, voffA);
        if (wr == 1) PG8_BAR;
        PG8_WAIT_V(4); PG8_BAR;
        PG8_STAGE(PG8_SB(1, 0), cB + kstep, voffB); PG8_STAGE(PG8_SA(1, 0), cA + kstep, voffA); PG8_STAGE(PG8_SB(1, 1), cB + hstep + kstep, voffB);
        PG8_WAIT_V(6); PG8_BAR;
    }
    for (;;) {
        const bool has_next = S.next(ui + 1, nxt);
        const char* nA = has_next ? (const char*)g.A + (size_t)nxt.pm * tstep : cA; const char* nB = has_next ? (const char*)g.Bt + (size_t)nxt.pn * tstep : cB;
        _Pragma("unroll 1") for (int t = 0; t < nt; t += 2) {
            const bool last = (t == nt - 2);
            const char* a1 = cA + (size_t)(t + 1) * kstep;
            const char* a2 = last ? nA : cA + (size_t)(t + 2) * kstep; const char* b2 = last ? nB : cB + (size_t)(t + 2) * kstep;
            const char* a3 = a2 + kstep; const char* b3 = b2 + kstep;
            if (last && has_next) S.a_ready(nxt);
            if constexpr (SP2) {
            PG8_LDB(B0, 0, 0); PG8_LDB(B1, 0, 1); PG8_SCHED; PG8_LDA(At, 0, 0); PG8_STAGE(PG8_SA(1, 1), a1 + hstep, voffA);
            PG8_WAIT_V(8); PG8_WAIT_L(0); PG8_BAR; PG8_MMA(0, 0, At, B0); PG8_MMA(0, 1, At, B1); PG8_BAR; PG8_SCHED;
            PG8_LDA(At, 0, 1); PG8_STAGE(PG8_SB(0, 0), b2, voffB); PG8_STAGE(PG8_SB(0, 1), b2 + hstep, voffB); PG8_STAGE(PG8_SA(0, 0), a2, voffA);
            PG8_WAIT_V(8); PG8_WAIT_L(0); PG8_BAR; PG8_MMA(1, 0, At, B0); PG8_MMA(1, 1, At, B1); PG8_BAR; PG8_SCHED;
            PG8_LDB(B0, 1, 0); PG8_LDB(B1, 1, 1); PG8_SCHED; PG8_LDA(At, 1, 0); PG8_STAGE(PG8_SA(0, 1), a2 + hstep, voffA);
            PG8_WAIT_V(8); PG8_WAIT_L(0); PG8_BAR; PG8_MMA(0, 0, At, B0); PG8_MMA(0, 1, At, B1); PG8_BAR; PG8_SCHED;
            PG8_LDA(At, 1, 1); PG8_STAGE(PG8_SB(1, 0), b3, voffB); PG8_STAGE(PG8_SB(1, 1), b3 + hstep, voffB); PG8_STAGE(PG8_SA(1, 0), a3, voffA);
            PG8_WAIT_V(8); PG8_WAIT_L(0); PG8_BAR; PG8_MMA(1, 0, At, B0); PG8_MMA(1, 1, At, B1); PG8_BAR; PG8_SCHED;
            } else {
            PG8_LDB(B0, 0, 0); PG8_SCHED; PG8_LDA(At, 0, 0); PG8_STAGE(PG8_SA(1, 1), a1 + hstep, voffA);
            PG8_WAIT_L(8); PG8_BAR; PG8_WAIT_L(0); PG8_MMA(0, 0, At, B0); PG8_BAR; PG8_SCHED;
            PG8_LDB(B1, 0, 1); PG8_STAGE(PG8_SB(0, 0), b2, voffB);
            PG8_BAR; PG8_WAIT_L(0); PG8_MMA(0, 1, At, B1); PG8_BAR;
            PG8_LDA(At, 0, 1); PG8_STAGE(PG8_SA(0, 0), a2, voffA);
            PG8_BAR; PG8_WAIT_L(0); PG8_MMA(1, 0, At, B0); PG8_BAR; PG8_SCHED;
            PG8_STAGE(PG8_SB(0, 1), b2 + hstep, voffB);
            PG8_WAIT_V(6); PG8_BAR; PG8_MMA(1, 1, At, B1); PG8_BAR;
            PG8_LDB(B0, 1, 0); PG8_SCHED; PG8_LDA(At, 1, 0); PG8_STAGE(PG8_SA(0, 1), a2 + hstep, voffA);
            PG8_WAIT_L(8); PG8_BAR; PG8_WAIT_L(0); PG8_MMA(0, 0, At, B0); PG8_BAR; PG8_SCHED;
            PG8_LDB(B1, 1, 1); PG8_STAGE(PG8_SB(1, 0), b3, voffB);
            PG8_BAR; PG8_WAIT_L(0); PG8_MMA(0, 1, At, B1); PG8_BAR;
            PG8_LDA(At, 1, 1); PG8_STAGE(PG8_SA(1, 0), a3, voffA);
            PG8_BAR; PG8_WAIT_L(0); PG8_MMA(1, 0, At, B0); PG8_BAR; PG8_SCHED;
            PG8_STAGE(PG8_SB(1, 1), b3 + hstep, voffB);
            PG8_WAIT_V(6); PG8_BAR; PG8_MMA(1, 1, At, B1); PG8_BAR;
            }
        }
        if constexpr (ALIGN_EPI) { if (wr == 0) PG8_BAR; }
        if constexpr (!Epi::AFTER_DRAIN) { E(acc, cur, wr, wc, fr, fq); S.done(cur); }
        if (!has_next) break;
#pragma unroll
        for (int a = 0; a < 2; ++a)
#pragma unroll
            for (int b = 0; b < 2; ++b)
#pragma unroll
                for (int m = 0; m < 4; ++m)
#pragma unroll
                    for (int n = 0; n < 2; ++n) acc[a][b][m][n] = (f32x4){0.f, 0.f, 0.f, 0.f};
        cur = nxt; cA = nA; cB = nB; ++ui;
        if constexpr (ALIGN_EPI) { if (wr == 1) PG8_BAR; }
    }
    PG8_WAIT_V(0);
    if constexpr (!ALIGN_EPI) { if (wr == 0) PG8_BAR; }
    PG8_BAR;
    if constexpr (Epi::AFTER_DRAIN) { E.fused(acc, cur, wr, wc, fr, fq, lds, wid, lane); S.done(cur); }
#undef PG8_SA
#undef PG8_SB
#undef PG8_STAGE
#undef PG8_LDA
#undef PG8_LDB
#undef PG8_MMA
#undef PG8_WAIT_V
#undef PG8_WAIT_L
#undef PG8_BAR
#undef PG8_SCHED
}
}

namespace mix {
#define MIX_LAS __attribute__((address_space(3)))
typedef unsigned short bf16_t;
typedef short bf16x8 __attribute__((ext_vector_type(8)));
typedef short s16x4 __attribute__((ext_vector_type(4)));
typedef float f32x4 __attribute__((ext_vector_type(4)));
typedef float f32x2 __attribute__((ext_vector_type(2)));
typedef float f32x16 __attribute__((ext_vector_type(16)));
typedef unsigned u32x4 __attribute__((ext_vector_type(4)));
typedef unsigned u32x2 __attribute__((ext_vector_type(2)));
typedef MIX_LAS unsigned char* ldsp;
constexpr int ZP = 3072;
constexpr int ZC_GQ = 0, ZC_GK = 256, ZC_GV = 512, ZC_GR = 1024, ZC_RQ = 1536, ZC_RK = 1792, ZC_RV = 2048, ZC_RG = 2560;
constexpr int SEQ = 4096, NCH = 64;
#define MFMA32(a, b, c) __builtin_amdgcn_mfma_f32_32x32x16_bf16((a), (b), (c), 0, 0, 0)
#define MFMA32F(a, b, c) __builtin_amdgcn_mfma_f32_32x32x2f32((a), (b), (c), 0, 0, 0)
__device__ __forceinline__ int crow(int r, int h) { return (r & 3) + 8 * (r >> 2) + 4 * h; }
__device__ __forceinline__ unsigned pk2(float lo, float hi) { return pg8::cvt_pk_bf16(lo, hi); }
__device__ __forceinline__ float lo16(unsigned w) { return __uint_as_float(w << 16); }
__device__ __forceinline__ float hi16(unsigned w) { return __uint_as_float(w & 0xffff0000u); }
__device__ __forceinline__ bf16x8 mk8(u32x2 lo, u32x2 hi) { u32x4 v; v.x = lo.x; v.y = lo.y; v.z = hi.x; v.w = hi.y; return __builtin_bit_cast(bf16x8, v); }
__device__ __forceinline__ void ld_dfrag(const bf16_t* rowp, int ks, int h, u32x2& lo, u32x2& hi) { lo = *(const u32x2*)(rowp + 16 * ks + 4 * h); hi = *(const u32x2*)(rowp + 16 * ks + 8 + 4 * h); }
__device__ __forceinline__ bf16x8 scale8(u32x2 lo, u32x2 hi, const float (&f)[8]) {
    u32x4 v; v.x = pk2(lo16(lo.x) * f[0], hi16(lo.x) * f[1]); v.y = pk2(lo16(lo.y) * f[2], hi16(lo.y) * f[3]); v.z = pk2(lo16(hi.x) * f[4], hi16(hi.x) * f[5]); v.w = pk2(lo16(hi.y) * f[6], hi16(hi.y) * f[7]);
    return __builtin_bit_cast(bf16x8, v);
}
__device__ __forceinline__ bf16x8 scale8s(u32x2 lo, u32x2 hi, float f) {
    u32x4 v; v.x = pk2(lo16(lo.x) * f, hi16(lo.x) * f); v.y = pk2(lo16(lo.y) * f, hi16(lo.y) * f); v.z = pk2(lo16(hi.x) * f, hi16(hi.x) * f); v.w = pk2(lo16(hi.y) * f, hi16(hi.y) * f);
    return __builtin_bit_cast(bf16x8, v);
}
__device__ __forceinline__ bf16x8 pack_step(const f32x16& x, int s) {
    u32x4 v; v.x = pk2(x[8 * s], x[8 * s + 1]); v.y = pk2(x[8 * s + 2], x[8 * s + 3]); v.z = pk2(x[8 * s + 4], x[8 * s + 5]); v.w = pk2(x[8 * s + 6], x[8 * s + 7]);
    return __builtin_bit_cast(bf16x8, v);
}
typedef short v4i16_t __attribute__((ext_vector_type(4)));
__device__ __forceinline__ s16x4 tr4(ldsp p) { return __builtin_bit_cast(s16x4, __builtin_amdgcn_ds_read_tr16_b64_v4i16((MIX_LAS v4i16_t*)p)); }
__device__ __forceinline__ bf16x8 tr_frag(ldsp tile, int RS, int rb0, int rb1, int cb, int lane) {
    const int q = (lane & 15) >> 2, p = lane & 3, blk = (lane >> 4) & 1; const int coff = (cb + 16 * blk + 4 * p) * 2;
    const s16x4 a = tr4(tile + (rb0 + q) * RS + coff), b = tr4(tile + (rb1 + q) * RS + coff);
    return (bf16x8){a[0], a[1], a[2], a[3], b[0], b[1], b[2], b[3]};
}
template <int NC> __device__ __forceinline__ void tile_to_lds(const bf16_t* g, ldsp tile, int lane) {
    constexpr int CPR = NC / 8, RPS = 64 / CPR;
    const bf16_t* gb = g + (size_t)(lane / CPR) * ZP + (lane % CPR) * 8; const ldsp lb = tile + (lane / CPR) * (NC * 2) + (lane % CPR) * 16;
#pragma unroll
    for (int i = 0; i < CPR; ++i) { const u32x4 v = *(const u32x4*)(gb + (size_t)i * RPS * ZP); *(MIX_LAS u32x4*)(lb + i * RPS * (NC * 2)) = v; }
}
__device__ __forceinline__ float ret_log_gamma(int hd) { return logf(1.0f - exp2f(-5.0f - (float)hd)); }

__device__ __forceinline__ void gla_cum(f32x16 (&L)[2][2], const float* wgu, const float* bias, const float* glr, int row0, int hd, int lane) {
    const int c = lane & 31, h = lane >> 5;
#pragma unroll
    for (int cd = 0; cd < 2; ++cd)
#pragma unroll
        for (int g = 0; g < 4; ++g) { const f32x4 bv = *(const f32x4*)(bias + hd * 64 + 32 * cd + 8 * g + 4 * h);
#pragma unroll
            for (int e = 0; e < 4; ++e) { L[cd][0][4 * g + e] = bv[e]; L[cd][1][4 * g + e] = bv[e]; } }
#pragma unroll
    for (int kk = 0; kk < 8; ++kk) {
        const float a0 = wgu[(2 * kk + h) * 256 + hd * 64 + c], a1 = wgu[(2 * kk + h) * 256 + hd * 64 + 32 + c];
        const float b0 = glr[(size_t)(row0 + c) * 16 + 2 * kk + h], b1 = glr[(size_t)(row0 + 32 + c) * 16 + 2 * kk + h];
        L[0][0] = MFMA32F(a0, b0, L[0][0]); L[0][1] = MFMA32F(a0, b1, L[0][1]); L[1][0] = MFMA32F(a1, b0, L[1][0]); L[1][1] = MFMA32F(a1, b1, L[1][1]);
    }
#pragma unroll
    for (int cd = 0; cd < 2; ++cd)
#pragma unroll
        for (int r = 0; r < 16; ++r) {
            float x0 = L[cd][0][r], x1 = L[cd][1][r];
            x0 = (fminf(x0, 0.f) - __logf(1.0f + __expf(-fabsf(x0)))) * 0.0625f; x1 = (fminf(x1, 0.f) - __logf(1.0f + __expf(-fabsf(x1)))) * 0.0625f;
#pragma unroll
            for (int s = 1; s < 32; s <<= 1) { const float y0 = __shfl_up(x0, s, 32), y1 = __shfl_up(x1, s, 32); if (c >= s) { x0 += y0; x1 += y1; } }
            x1 += __shfl(x0, 31, 32);
            L[cd][0][r] = x0; L[cd][1][r] = x1;
        }
}

struct MixPtrs {
    const bf16_t* Z; const float* GLR; bf16_t* ST; float* DEC; float* CUM; bf16_t* Y;
    const float* wgu; const float* bgate; const float* g_gla; const float* g_ret;
};

template <int KIND> __device__ __forceinline__ void m1_unit(const MixPtrs& P, int u, ldsp lds, int lane) {
    asm volatile("" : "+v"(lane));
    const int c = lane & 31, h = lane >> 5;
    const int n = u & 63, hd = (u >> 6) & 3, b = u >> 8, row0 = b * SEQ + n * 64, gh = KIND * 16 + b * 4 + hd;
    const ldsp Kt = lds, Vt = lds + 8192;
    const bf16_t* zk = P.Z + (size_t)row0 * ZP + (KIND == 0 ? ZC_GK : ZC_RK) + hd * 64;
    if (KIND == 0) {
        f32x16 L[2][2]; gla_cum(L, P.wgu, P.bgate, P.GLR, row0, hd, lane);
#pragma unroll
        for (int t = 0; t < 2; ++t) { float* cp = P.CUM + (size_t)u * 4096 + t * 2048 + lane * 32;
#pragma unroll
            for (int cd = 0; cd < 2; ++cd)
#pragma unroll
                for (int s = 0; s < 2; ++s) {
                    *(f32x4*)(cp + (cd * 2 + s) * 8) = (f32x4){L[cd][t][8 * s], L[cd][t][8 * s + 1], L[cd][t][8 * s + 2], L[cd][t][8 * s + 3]};
                    *(f32x4*)(cp + (cd * 2 + s) * 8 + 4) = (f32x4){L[cd][t][8 * s + 4], L[cd][t][8 * s + 5], L[cd][t][8 * s + 6], L[cd][t][8 * s + 7]}; } }
#pragma unroll
        for (int cd = 0; cd < 2; ++cd) {
            f32x16 CL;
#pragma unroll
            for (int r = 0; r < 16; ++r) CL[r] = __shfl(L[cd][1][r], 31, 32);
            if (c == 0) {
#pragma unroll
                for (int r = 0; r < 16; ++r) P.DEC[(size_t)u * 64 + 32 * cd + crow(r, h)] = __expf(CL[r]); }
#pragma unroll
            for (int t = 0; t < 2; ++t)
#pragma unroll
                for (int s = 0; s < 2; ++s) { const int ks = 2 * cd + s; u32x2 lo, hi; ld_dfrag(zk + (size_t)(32 * t + c) * ZP, ks, h, lo, hi);
                    float f[8];
#pragma unroll
                    for (int jj = 0; jj < 8; ++jj) f[jj] = __expf(CL[8 * s + jj] - L[cd][t][8 * s + jj]);
                    const u32x4 v = __builtin_bit_cast(u32x4, scale8(lo, hi, f));
                    const ldsp kp = Kt + (32 * t + c) * 128 + (16 * ks + 4 * h) * 2;
                    *(MIX_LAS u32x2*)kp = (u32x2){v.x, v.y}; *(MIX_LAS u32x2*)(kp + 16) = (u32x2){v.z, v.w}; }
        }
    } else {
        const float lg = ret_log_gamma(hd);
#pragma unroll
        for (int t = 0; t < 2; ++t) { const float w = __expf(lg * (float)(63 - (32 * t + c)));
#pragma unroll
            for (int ks = 0; ks < 4; ++ks) { u32x2 lo, hi; ld_dfrag(zk + (size_t)(32 * t + c) * ZP, ks, h, lo, hi);
                const u32x4 v = __builtin_bit_cast(u32x4, scale8s(lo, hi, w));
                const ldsp kp = Kt + (32 * t + c) * 128 + (16 * ks + 4 * h) * 2;
                *(MIX_LAS u32x2*)kp = (u32x2){v.x, v.y}; *(MIX_LAS u32x2*)(kp + 16) = (u32x2){v.z, v.w}; } }
    }
    const bf16_t* zv = P.Z + (size_t)row0 * ZP + (KIND == 0 ? ZC_GV : ZC_RV) + hd * 128;
    bf16_t* st = P.ST + ((size_t)gh * NCH + n) * 8192;
#pragma unroll 1
    for (int vh = 0; vh < 2; ++vh) {
        tile_to_lds<64>(zv + vh * 64, Vt, lane);
        f32x16 acc[2][2];
#pragma unroll
        for (int a = 0; a < 2; ++a)
#pragma unroll
            for (int bq = 0; bq < 2; ++bq)
#pragma unroll
                for (int r = 0; r < 16; ++r) acc[a][bq][r] = 0.f;
#pragma unroll
        for (int kj = 0; kj < 4; ++kj) { const int rb = 16 * kj + 8 * h;
            const bf16x8 a0 = tr_frag(Vt, 128, rb, rb + 4, 0, lane), a1 = tr_frag(Vt, 128, rb, rb + 4, 32, lane);
            const bf16x8 b0 = tr_frag(Kt, 128, rb, rb + 4, 0, lane), b1 = tr_frag(Kt, 128, rb, rb + 4, 32, lane);
            acc[0][0] = MFMA32(a0, b0, acc[0][0]); acc[0][1] = MFMA32(a0, b1, acc[0][1]); acc[1][0] = MFMA32(a1, b0, acc[1][0]); acc[1][1] = MFMA32(a1, b1, acc[1][1]); }
#pragma unroll
        for (int cvl = 0; cvl < 2; ++cvl)
#pragma unroll
            for (int cd = 0; cd < 2; ++cd)
#pragma unroll
                for (int r = 0; r < 16; r += 2) {
                    bf16_t* p0 = st + (size_t)(vh * 64 + 32 * cvl + crow(r, h)) * 64 + 32 * cd + c; const unsigned w = pk2(acc[cvl][cd][r], acc[cvl][cd][r + 1]);
                    p0[0] = (bf16_t)(w & 0xffffu); p0[64] = (bf16_t)(w >> 16); }
    }
}

#define MIX_FENCE() asm volatile("" ::: "memory")
template <int KIND> __device__ __forceinline__ void m3_unit(const MixPtrs& P, int u, ldsp lds, int lane) {
    asm volatile("" : "+v"(lane));
    const int c = lane & 31, h = lane >> 5;
    const int n = u & 63, hd = (u >> 6) & 3, b = u >> 8, row0 = b * SEQ + n * 64, gh = KIND * 16 + b * 4 + hd;
    const bf16_t* zq = P.Z + (size_t)row0 * ZP + (KIND == 0 ? ZC_GQ : ZC_RQ) + hd * 64;
    const bf16_t* zk = P.Z + (size_t)row0 * ZP + (KIND == 0 ? ZC_GK : ZC_RK) + hd * 64;
    const bf16_t* zv = P.Z + (size_t)row0 * ZP + (KIND == 0 ? ZC_GV : ZC_RV) + hd * 128;
    const bf16_t* zr = P.Z + (size_t)row0 * ZP + (KIND == 0 ? ZC_GR : ZC_RG) + hd * 128;
    const bf16_t* pt = P.ST + ((size_t)gh * NCH + n) * 8192;
    const float* gn = (KIND == 0 ? P.g_gla : P.g_ret) + hd * 128;
    const float* cum = P.CUM + (size_t)u * 4096 + lane * 32;
    const float lg = ret_log_gamma(hd);
    tile_to_lds<128>(zv, lds, lane);
#pragma unroll 1
    for (int ti = 0; ti < 2; ++ti) {
        const int i = 32 * ti + c;
        bf16x8 qf[4];
        const bf16_t* qrow = zq + (size_t)i * ZP;
#pragma unroll
        for (int ks = 0; ks < 4; ++ks) { u32x2 lo, hi; ld_dfrag(qrow, ks, h, lo, hi);
            if (KIND == 0) { const float* cp = cum + ti * 2048 + ks * 8; const f32x4 c0 = *(const f32x4*)cp, c1 = *(const f32x4*)(cp + 4);
                float fp[8];
#pragma unroll
                for (int e = 0; e < 4; ++e) { fp[e] = __expf(c0[e]); fp[4 + e] = __expf(c1[e]); }
                qf[ks] = scale8(lo, hi, fp);
            } else { qf[ks] = mk8(lo, hi); } }
        MIX_FENCE();
        bf16x8 spk[2][2];
#pragma unroll
        for (int tj = 0; tj < 2; ++tj) {
            f32x16 T;
            const bf16_t* krow = zk + (size_t)(32 * tj + c) * ZP;
            if (KIND == 0) {
                const bool need_f = (tj <= ti), need_b = (tj >= ti);
                f32x16 F, Bw;
#pragma unroll
                for (int r = 0; r < 16; ++r) { F[r] = 0.f; Bw[r] = 0.f; }
                if (need_f) {
#pragma unroll
                    for (int ks = 0; ks < 4; ++ks) { u32x2 lo, hi; ld_dfrag(krow, ks, h, lo, hi);
                        const float* cp = cum + tj * 2048 + ks * 8; const f32x4 c0 = *(const f32x4*)cp, c1 = *(const f32x4*)(cp + 4);
                        float fn[8];
#pragma unroll
                        for (int e = 0; e < 4; ++e) { fn[e] = __expf(-c0[e]); fn[4 + e] = __expf(-c1[e]); }
                        F = MFMA32(scale8(lo, hi, fn), qf[ks], F); if (ks & 1) MIX_FENCE(); } }
                if (need_b) {
#pragma unroll
                    for (int ks = 0; ks < 4; ++ks) { u32x2 lo, hi, ql, qh; ld_dfrag(krow, ks, h, lo, hi); ld_dfrag(qrow, ks, h, ql, qh);
                        const float* cp = cum + tj * 2048 + ks * 8; const f32x4 c0 = *(const f32x4*)cp, c1 = *(const f32x4*)(cp + 4);
                        const float* cq = cum + ti * 2048 + ks * 8; const f32x4 q0 = *(const f32x4*)cq, q1 = *(const f32x4*)(cq + 4);
                        float fp[8], fn[8];
#pragma unroll
                        for (int e = 0; e < 4; ++e) { fp[e] = __expf(c0[e]); fp[4 + e] = __expf(c1[e]); fn[e] = __expf(-q0[e]); fn[4 + e] = __expf(-q1[e]); }
                        Bw = MFMA32(scale8(lo, hi, fp), scale8(ql, qh, fn), Bw); MIX_FENCE(); } }
#pragma unroll
                for (int r = 0; r < 16; ++r) { const int j = 32 * tj + crow(r, h); T[r] = need_f ? ((need_b && i < j) ? Bw[r] : F[r]) : Bw[r]; }
            } else {
#pragma unroll
                for (int r = 0; r < 16; ++r) T[r] = 0.f;
#pragma unroll
                for (int ks = 0; ks < 4; ++ks) { u32x2 lo, hi; ld_dfrag(krow, ks, h, lo, hi); T = MFMA32(mk8(lo, hi), qf[ks], T); }
#pragma unroll
                for (int r = 0; r < 16; ++r) { const int j = 32 * tj + crow(r, h); const int dist = i >= j ? i - j : j - i; T[r] *= __expf(lg * (float)dist); }
            }
            spk[tj][0] = pack_step(T, 0); spk[tj][1] = pack_step(T, 1);
            MIX_FENCE();
        }
        f32x16 acc[4];
#pragma unroll
        for (int cv = 0; cv < 4; ++cv) {
#pragma unroll
            for (int r = 0; r < 16; ++r) acc[cv][r] = 0.f;
#pragma unroll
            for (int ks = 0; ks < 4; ++ks) { u32x2 lo, hi; ld_dfrag(pt + (size_t)(32 * cv + c) * 64, ks, h, lo, hi); acc[cv] = MFMA32(mk8(lo, hi), qf[ks], acc[cv]); }
            MIX_FENCE();
        }
        if (KIND == 1) { const float qd = __expf(lg * (float)(i + 1));
#pragma unroll
            for (int cv = 0; cv < 4; ++cv)
#pragma unroll
                for (int r = 0; r < 16; ++r) acc[cv][r] *= qd; }
#pragma unroll
        for (int cv = 0; cv < 4; ++cv) {
#pragma unroll
            for (int tj = 0; tj < 2; ++tj)
#pragma unroll
                for (int s = 0; s < 2; ++s) { const int rb = 32 * tj + 16 * s + 4 * h; acc[cv] = MFMA32(tr_frag(lds, 256, rb, rb + 8, 32 * cv, lane), spk[tj][s], acc[cv]); }
            MIX_FENCE();
        }
        float ss = 0.f;
#pragma unroll
        for (int cv = 0; cv < 4; ++cv)
#pragma unroll
            for (int r = 0; r < 16; ++r) ss += acc[cv][r] * acc[cv][r];
        ss += __shfl_xor(ss, 32);
        const float rs = 1.0f / sqrtf(ss * (1.0f / 128.0f) + pg8::RMS_EPS);
        bf16_t* yrow = P.Y + (size_t)(row0 + i) * 1024 + KIND * 512 + hd * 128;
        const bf16_t* rrow = zr + (size_t)i * ZP;
#pragma unroll
        for (int cv = 0; cv < 4; ++cv) {
#pragma unroll
            for (int g = 0; g < 4; ++g) { const int v0 = 32 * cv + 8 * g + 4 * h; const f32x4 gv = *(const f32x4*)(gn + v0); const u32x2 rw = *(const u32x2*)(rrow + v0);
                u32x2 w; w.x = pk2(acc[cv][4 * g] * rs * gv[0] * lo16(rw.x), acc[cv][4 * g + 1] * rs * gv[1] * hi16(rw.x));
                w.y = pk2(acc[cv][4 * g + 2] * rs * gv[2] * lo16(rw.y), acc[cv][4 * g + 3] * rs * gv[3] * hi16(rw.y));
                *(u32x2*)(yrow + v0) = w; }
            MIX_FENCE();
        }
    }
}

__device__ __forceinline__ void m2_scan(const MixPtrs& P, int T, int NT) {
    for (int pi = T; pi < 32 * 4096; pi += NT) {
        const int gh = pi >> 12, e = (pi & 4095) * 2, d = e & 63, hd = gh & 3;
        bf16_t* p = P.ST + (size_t)gh * NCH * 8192 + e;
        const bool isg = gh < 16;
        const float ar = __expf(ret_log_gamma(hd) * 64.0f);
        const float* dp = P.DEC + (size_t)(gh & 15) * NCH * 64 + d;
        float s0 = 0.f, s1 = 0.f;
#pragma unroll 8
        for (int n = 0; n < NCH; ++n) {
            const unsigned w = *(const unsigned*)(p + (size_t)n * 8192);
            float a0 = ar, a1 = ar;
            if (isg) { const f32x2 a = *(const f32x2*)(dp + n * 64); a0 = a[0]; a1 = a[1]; }
            *(unsigned*)(p + (size_t)n * 8192) = pk2(s0, s1);
            s0 = a0 * s0 + lo16(w); s1 = a1 * s1 + hi16(w);
        }
    }
}
}

#ifndef PHMASK
#define PHMASK 0xFFFF
#endif
constexpr int NWAVES = 8;
constexpr int BATCH = 4, SEQ = 4096, D = 1024, FF = 2816, PLE = 256, NZ = 3328  , IN_COLS = 3088;
constexpr int M = BATCH * SEQ;
constexpr size_t MiB = 1u << 20;
constexpr size_t WS_CTL = 0, CTL_ZERO_BYTES = 64 * 1024;
constexpr size_t WS_PARTA = 1 * MiB, WS_PARTB = 2 * MiB;
constexpr size_t WS_GLR = 3 * MiB;
constexpr size_t WS_COS = 4 * MiB, WS_SIN = 4 * MiB + 512 * 1024;
constexpr size_t WS_DEC = 5 * MiB;
constexpr size_t WS_W1 = 6 * MiB;
constexpr size_t WS_WD1 = 17 * MiB;
constexpr size_t WS_CUM = 6 * MiB;
constexpr size_t WS_WIN = 23 * MiB;
constexpr size_t WS_WOUT = 30 * MiB;
constexpr size_t WS_W2 = 32 * MiB;
constexpr size_t WS_WD2 = 43 * MiB;
constexpr size_t WS_WPG = 49 * MiB;
constexpr size_t WS_WPP = 51 * MiB;
constexpr size_t WS_PB = 52 * MiB;
constexpr size_t WS_HB = 60 * MiB;
constexpr size_t WS_BIG = 92 * MiB;
constexpr size_t WS_ST = 188 * MiB;
constexpr size_t WS_Y = 220 * MiB;
constexpr size_t WS_END = 252 * MiB;
static_assert(WS_WD1 + (size_t)D * FF * 2 <= WS_WIN && WS_CUM + 16 * MiB <= WS_WIN && WS_WIN + (size_t)NZ * D * 2 <= WS_WOUT && WS_WD2 + (size_t)D * FF * 2 <= WS_WPG, "weights map");
static_assert(WS_END <= 256 * MiB, "d_ws map");
constexpr int CW_BAR = 1024;
constexpr int RING_OFF = 0, RING_BYTES = 131072;
constexpr int LDSCTL_OFF = RING_BYTES, MISC_OFF = LDSCTL_OFF + 320;
constexpr int LDS_BYTES = 147456;
static_assert(MISC_OFF + 128 <= LDS_BYTES, "LDS map");

#define GAS __attribute__((address_space(1)))
#define LAS __attribute__((address_space(3)))
typedef unsigned short bf16;
typedef unsigned v4u __attribute__((ext_vector_type(4)));
typedef float f32x4 __attribute__((ext_vector_type(4)));
typedef GAS unsigned gu32;
#define RLX_AGENT __ATOMIC_RELAXED, __HIP_MEMORY_SCOPE_AGENT
#define LDS_WAIT() asm volatile("s_waitcnt lgkmcnt(0)" ::: "memory")
#define VM_WAIT() asm volatile("s_waitcnt vmcnt(0)" ::: "memory")
__device__ __forceinline__ unsigned pk2(float lo, float hi) { return pg8::cvt_pk_bf16(lo, hi); }

#define XB_TMO      128
#define XB_XCNT(j)  (256  + 64 * (j))
#define XB_XSUB(j)  (1280 + 64 * (j))
#define XB_XGEN(j)  (2304 + 64 * (j))
#define XB_TOP      3328
#define XB_TOPGEN   3392
#define XCD_BAR_WORDS 3456
#define XB_SPIN_CAP (1u << 18)
static_assert((CW_BAR + XCD_BAR_WORDS) * 4 <= (int)CTL_ZERO_BYTES, "barrier words inside the memset region");
__device__ __forceinline__ unsigned xb_ld(unsigned* p)              { return __hip_atomic_load(p, __ATOMIC_RELAXED, __HIP_MEMORY_SCOPE_AGENT); }
__device__ __forceinline__ unsigned xb_add(unsigned* p, unsigned v) { return __hip_atomic_fetch_add(p, v, __ATOMIC_RELAXED, __HIP_MEMORY_SCOPE_AGENT); }
__device__ __forceinline__ unsigned xb_xcc_id() { return (unsigned)__builtin_amdgcn_s_getreg((3 << 11) | 20) & 0xFu; }
#define XB_SPIN(cond, bar) do { unsigned _sp = 0; while (cond) { __builtin_amdgcn_s_sleep(1); \
    if ((++_sp & 255u) == 0u) { if (xb_ld(&(bar)[XB_TMO])) break; if (_sp > XB_SPIN_CAP) { atomicAdd(&(bar)[XB_TMO], 1u); break; } } } } while (0)
struct XcdBarrier { unsigned* bar; unsigned x; volatile LAS unsigned* st; int wave; };
__device__ __forceinline__ bool xb_thread0(int wave) { return wave == 0 && __builtin_amdgcn_mbcnt_hi(~0u, __builtin_amdgcn_mbcnt_lo(~0u, 0u)) == 0u; }
__device__ __forceinline__ XcdBarrier xcd_barrier_post(unsigned* bar, volatile LAS unsigned* st, int wave) {
    XcdBarrier b; b.bar = bar; b.x = xb_xcc_id(); b.st = st; b.wave = wave;
    if (xb_thread0(wave)) (void)xb_add(&bar[XB_XCNT(b.x)], 1u);
    return b;
}
__device__ __forceinline__ void xcd_barrier_complete(unsigned* bar, unsigned x, unsigned& nloc, unsigned& nx) {
    const unsigned G = gridDim.x * gridDim.y * gridDim.z;
    unsigned sum, cnt, mine, sp = 0u;
    for (;;) {
        sum = 0u; cnt = 0u; mine = 0u;
#pragma unroll
        for (unsigned j = 0; j < 16; ++j) { const unsigned c = xb_ld(&bar[XB_XCNT(j)]); sum += c; cnt += (c > 0u) ? 1u : 0u; mine = (j == x) ? c : mine; }
        if (sum == G) break;
        __builtin_amdgcn_s_sleep(1);
        if ((++sp & 255u) == 0u) { if (xb_ld(&bar[XB_TMO])) break; if (sp > XB_SPIN_CAP) { atomicAdd(&bar[XB_TMO], 1u); break; } }
    }
    nloc = mine > 0u ? mine : 1u; nx = cnt > 0u ? cnt : 1u;
}
__device__ __forceinline__ void xcd_barrier(const XcdBarrier& b) {
    asm volatile("s_waitcnt vmcnt(0)" ::: "memory");
    __syncthreads();
    if (xb_thread0(b.wave)) {
        unsigned* bar = b.bar;
        __builtin_amdgcn_s_waitcnt(0);
        unsigned nloc = b.st[0], nx = b.st[1];
        if (nloc == 0u) { xcd_barrier_complete(bar, b.x, nloc, nx); b.st[0] = nloc; b.st[1] = nx; }
        const unsigned old = xb_add(&bar[XB_XSUB(b.x)], 1u);
        const unsigned gen = old / nloc;
        if (old + 1u == (gen + 1u) * nloc) {
            __builtin_amdgcn_fence(__ATOMIC_RELEASE, "agent");
            asm volatile("s_waitcnt vmcnt(0)" ::: "memory");
            const unsigned og = xb_add(&bar[XB_TOP], 1u);
            const unsigned tg = og / nx;
            if (og + 1u == (tg + 1u) * nx) xb_add(&bar[XB_TOPGEN], 1u);
            else XB_SPIN(xb_ld(&bar[XB_TOPGEN]) == tg, bar);
            __builtin_amdgcn_fence(__ATOMIC_ACQUIRE, "agent");
            xb_add(&bar[XB_XGEN(b.x)], 1u);
            asm volatile("s_waitcnt vmcnt(0)" ::: "memory");
        } else {
            XB_SPIN(xb_ld(&bar[XB_XGEN(b.x)]) == gen, bar);
            __builtin_amdgcn_fence(__ATOMIC_ACQUIRE, "agent");
            asm volatile("s_waitcnt vmcnt(0)" ::: "memory");
        }
    }
    __syncthreads();
}

__device__ __forceinline__ float wave_sum(float v) {
#pragma unroll
    for (int o = 1; o < 64; o <<= 1) v += __shfl_xor(v, o);
    return v;
}
__device__ __forceinline__ void p0_item(const float* W, int K, int N, const float* gain, bf16* WT, int k0, int c0, int nvalid, int dst0, LAS float* scr, int lane) {
#pragma unroll 8
    for (int i = 0; i < 32; ++i) { const int kk = 2 * i + (lane >> 5), cc = lane & 31;
        float v = 0.f; if (cc < nvalid) { v = W[(size_t)(k0 + kk) * N + c0 + cc]; if (gain) v *= gain[k0 + kk]; }
        scr[kk * 33 + cc] = v; }
    LDS_WAIT(); asm volatile("" ::: "memory");
    const int c = lane & 7;
#pragma unroll
    for (int j = 0; j < 4; ++j) { const int n = (lane >> 3) + 8 * j; const LAS float* s = scr + (8 * c) * 33 + n;
        v4u o; o.x = pk2(s[0 * 33], s[1 * 33]); o.y = pk2(s[2 * 33], s[3 * 33]); o.z = pk2(s[4 * 33], s[5 * 33]); o.w = pk2(s[6 * 33], s[7 * 33]);
        *(GAS v4u*)(WT + (size_t)(dst0 + n) * K + k0 + 8 * c) = o; }
    LDS_WAIT(); asm volatile("" ::: "memory");
}
__device__ __forceinline__ void win_group(int dst0, int& c0, int& nvalid) {
    nvalid = 32;
    if (dst0 < 1536) { c0 = dst0; return; }
    if (dst0 < 2048) {
        const int seg = (dst0 - 1536) >> 8, p = (dst0 - 1536) & 255, bj = p >> 7, hd = (p >> 5) & 3;
        c0 = 1552 + seg * 256 + hd * 64 + bj * 32; return; }
    if (dst0 < 3072) { c0 = dst0 + 16; return; }
    if (dst0 == 3072) { c0 = 1536; nvalid = 16; return; }
    c0 = 0; nvalid = 0;
}

struct KArgs { const float* in[21]; float* out; unsigned char* ws; };

__global__ void __launch_bounds__(NWAVES * 64, 2) hymba_fwd(KArgs args) {
    extern __shared__ __attribute__((aligned(16))) unsigned char lds_raw[];
    LAS unsigned char* lds = (LAS unsigned char*)lds_raw;
    volatile LAS unsigned* MISC = (volatile LAS unsigned*)(lds + MISC_OFF);
    const int wave = __builtin_amdgcn_readfirstlane((int)threadIdx.x >> 6);
#define PHASE_TID() int lane = (int)__builtin_amdgcn_mbcnt_hi(~0u, __builtin_amdgcn_mbcnt_lo(~0u, 0u)); asm volatile("" : "+v"(lane)); const int tid = wave * 64 + lane; (void)tid
    const int G = gridDim.x; const int bx = blockIdx.x; const int vcu = (G % 8 == 0) ? (bx % 8) * (G / 8) + bx / 8 : bx;
    unsigned char* ws = args.ws;
    const float* x = args.in[0]; const float* pin = args.in[1]; const float* g_ffn1 = args.in[2]; const float* w1g = args.in[3]; const float* w1u = args.in[4]; const float* w1d = args.in[5];
    const float* g_mix = args.in[6]; const float* w_in = args.in[7]; const float* wgu = args.in[8]; const float* bgate = args.in[9]; const float* g_gla = args.in[10]; const float* g_ret = args.in[11];
    const float* w_out = args.in[12]; const float* g_ffn2 = args.in[13]; const float* w2g = args.in[14]; const float* w2u = args.in[15]; const float* w2d = args.in[16];
    const float* g_ple = args.in[17]; const float* w_pg = args.in[18]; const float* w_pp = args.in[19]; const float* g_final = args.in[20];
    float* out = args.out;
    gu32* ctl = (gu32*)(ws + WS_CTL);
    float* PARTA = (float*)(ws + WS_PARTA); float* PARTB = (float*)(ws + WS_PARTB); float* GLR = (float*)(ws + WS_GLR);
    float* COS = (float*)(ws + WS_COS); float* SIN = (float*)(ws + WS_SIN); float* DEC = (float*)(ws + WS_DEC); float* CUM = (float*)(ws + WS_CUM);
    bf16* W1T = (bf16*)(ws + WS_W1); bf16* WD1T = (bf16*)(ws + WS_WD1); bf16* WINT = (bf16*)(ws + WS_WIN); bf16* WOUTT = (bf16*)(ws + WS_WOUT);
    bf16* W2T = (bf16*)(ws + WS_W2); bf16* WD2T = (bf16*)(ws + WS_WD2); bf16* WPGT = (bf16*)(ws + WS_WPG); bf16* WPPT = (bf16*)(ws + WS_WPP);
    bf16* PB = (bf16*)(ws + WS_PB); bf16* HB = (bf16*)(ws + WS_HB); bf16* BIG = (bf16*)(ws + WS_BIG); bf16* ST = (bf16*)(ws + WS_ST); bf16* Y = (bf16*)(ws + WS_Y);

    for (int u = threadIdx.x; u < (LDS_BYTES - LDSCTL_OFF) / 4; u += NWAVES * 64) ((LAS unsigned*)(lds + LDSCTL_OFF))[u] = 0u;
    __syncthreads();
    XcdBarrier bar = xcd_barrier_post((unsigned*)(ctl + CW_BAR), MISC + 8, wave);
#define GRID_BAR() xcd_barrier(bar)
    const int gw = vcu * NWAVES + wave, NGW = G * NWAVES;

    if (PHMASK & 1) {
        PHASE_TID();
        LAS float* scr = (LAS float*)(lds + RING_OFF + wave * 16384);
        constexpr int I_GU = (D / 64) * (FF / 32), I_DN = (FF / 64) * (D / 32), I_IN = (D / 64) * (NZ / 32), I_SQ = (D / 64) * (D / 32), I_PP = (PLE / 64) * (D / 32);
        constexpr int NITEMS = 4 * I_GU + 2 * I_DN + I_IN + 2 * I_SQ + I_PP;
        for (int it = gw; it < NITEMS; it += NGW) {
            int r = it;
            if (r < 4 * I_GU) {
                const int which = r / I_GU; r -= which * I_GU; const int kb = r / (FF / 32), nb = r % (FF / 32), j0 = nb * 32;
                const float* W = which == 0 ? w1g : which == 1 ? w1u : which == 2 ? w2g : w2u; const float* gain = which < 2 ? g_ffn1 : g_ffn2; bf16* WT = which < 2 ? W1T : W2T;
                p0_item(W, D, FF, gain, WT, kb * 64, j0, 32, 256 * (j0 >> 7) + 128 * (which & 1) + (j0 & 127), scr, lane); continue; }
            r -= 4 * I_GU;
            if (r < 2 * I_DN) { const int which = r / I_DN; r -= which * I_DN; const int kb = r / (D / 32), nb = r % (D / 32);
                p0_item(which == 0 ? w1d : w2d, FF, D, nullptr, which == 0 ? WD1T : WD2T, kb * 64, nb * 32, 32, nb * 32, scr, lane); continue; }
            r -= 2 * I_DN;
            if (r < I_IN) { const int kb = r / (NZ / 32), nb = r % (NZ / 32); int c0, nv; win_group(nb * 32, c0, nv);
                p0_item(w_in, D, IN_COLS, g_mix, WINT, kb * 64, c0, nv, nb * 32, scr, lane); continue; }
            r -= I_IN;
            if (r < 2 * I_SQ) { const int which = r / I_SQ; r -= which * I_SQ; const int kb = r / (D / 32), nb = r % (D / 32);
                p0_item(which == 0 ? w_out : w_pg, D, D, which == 0 ? nullptr : g_ple, which == 0 ? WOUTT : WPGT, kb * 64, nb * 32, 32, nb * 32, scr, lane); continue; }
            r -= 2 * I_SQ;
            { const int kb = r / (D / 32), nb = r % (D / 32); p0_item(w_pp, PLE, D, nullptr, WPPT, kb * 64, nb * 32, 32, nb * 32, scr, lane); }
        }
        for (int m = gw; m < M; m += NGW) {
            const GAS f32x4* xr = (const GAS f32x4*)(x + (size_t)m * D) + lane; f32x4 v[4]; float s = 0.f;
#pragma unroll
            for (int j = 0; j < 4; ++j) { v[j] = xr[64 * j]; s += (v[j].x * v[j].x + v[j].y * v[j].y) + (v[j].z * v[j].z + v[j].w * v[j].w); }
            s = wave_sum(s);
            GAS unsigned long long* o8 = (GAS unsigned long long*)(HB + (size_t)m * D) + lane;
#pragma unroll
            for (int j = 0; j < 4; ++j) o8[64 * j] = (unsigned long long)pk2(v[j].x, v[j].y) | ((unsigned long long)pk2(v[j].z, v[j].w) << 32);
            if (lane < 16) PARTA[(size_t)m * 16 + lane] = lane == 0 ? s : 0.f;
        }
        for (int m = gw; m < M; m += NGW) { const f32x4 v = *((const GAS f32x4*)(pin + (size_t)m * PLE) + lane);
            *((GAS unsigned long long*)(PB + (size_t)m * PLE) + lane) = (unsigned long long)pk2(v.x, v.y) | ((unsigned long long)pk2(v.z, v.w) << 32); }
        for (int e = bx * (NWAVES * 64) + tid; e < SEQ * 32; e += G * NWAVES * 64) { const int pos = e >> 5, i = e & 31;
            const float inv = powf(10000.0f, -(float)i / 32.0f); const float ang = (float)pos * inv; COS[e] = cosf(ang); SIN[e] = sinf(ang); }
    }
    GRID_BAR();

    if (PHMASK & 2) { pg8::Gemm g{HB, W1T, M, 2 * FF, D}; pg8::StaticOrder S; S.init(M, 2 * FF, G, bx);
      pg8::EpiSwiGLU E{BIG, FF, PARTA};
      pg8::gemm_phase<pg8::EpiSwiGLU, pg8::StaticOrder, true, true>(lds + RING_OFF, g, S, E, wave); }
    GRID_BAR();
    if (PHMASK & 4) { pg8::Gemm g{BIG, WD1T, M, D, FF}; pg8::StaticOrder S; S.init(M, D, G, bx);
      pg8::EpiResid E{x, out, HB, PARTB, 0.5f, D};
      pg8::gemm_phase<pg8::EpiResid, pg8::StaticOrder, true, true>(lds + RING_OFF, g, S, E, wave); }
    GRID_BAR();
    if (PHMASK & 8) { pg8::Gemm g{HB, WINT, M, NZ, D}; pg8::StaticOrder S; S.init(M, NZ, G, bx);
      pg8::EpiZ E{BIG, GLR, PARTB, COS, SIN};
      pg8::gemm_phase<pg8::EpiZ, pg8::StaticOrder, true, true>(lds + RING_OFF, g, S, E, wave); }
    GRID_BAR();
    const mix::MixPtrs MP{BIG, GLR, ST, DEC, CUM, Y, wgu, bgate, g_gla, g_ret};
    if (PHMASK & 16) {
        PHASE_TID();
        const mix::ldsp wl = lds + RING_OFF + wave * 16384;
        const int kind = wave >> 2;
        for (int u = vcu * 4 + (wave & 3); u < 1024; u += G * 4) { if (kind == 0) mix::m1_unit<0>(MP, u, wl, lane); else mix::m1_unit<1>(MP, u, wl, lane); }
    }
    GRID_BAR();
    if (PHMASK & 32) { PHASE_TID(); mix::m2_scan(MP, bx * (NWAVES * 64) + tid, G * NWAVES * 64); }
    GRID_BAR();
    if (PHMASK & 64) {
        PHASE_TID();
        const mix::ldsp wl = lds + RING_OFF + wave * 16384;
        const int kind = wave >> 2;
        for (int u = vcu * 4 + (wave & 3); u < 1024; u += G * 4) { if (kind == 0) mix::m3_unit<0>(MP, u, wl, lane); else mix::m3_unit<1>(MP, u, wl, lane); }
    }
    GRID_BAR();
    if (PHMASK & 128) { pg8::Gemm g{Y, WOUTT, M, D, D}; pg8::StaticOrder S; S.init(M, D, G, bx);
      pg8::EpiResid E{out, out, HB, PARTA, 1.0f, D};
      pg8::gemm_phase<pg8::EpiResid, pg8::StaticOrder, true, true>(lds + RING_OFF, g, S, E, wave); }
    GRID_BAR();
    if (PHMASK & 256) { pg8::Gemm g{HB, W2T, M, 2 * FF, D}; pg8::StaticOrder S; S.init(M, 2 * FF, G, bx);
      pg8::EpiSwiGLU E{BIG, FF, PARTA};
      pg8::gemm_phase<pg8::EpiSwiGLU, pg8::StaticOrder, true, true>(lds + RING_OFF, g, S, E, wave); }
    GRID_BAR();
    if (PHMASK & 512) { pg8::Gemm g{BIG, WD2T, M, D, FF}; pg8::StaticOrder S; S.init(M, D, G, bx);
      pg8::EpiResid E{out, out, HB, PARTB, 0.5f, D};
      pg8::gemm_phase<pg8::EpiResid, pg8::StaticOrder, true, true>(lds + RING_OFF, g, S, E, wave); }
    if (PHMASK & 1024) { pg8::Gemm g{PB, WPPT, M, D, PLE}; pg8::StaticOrder S; S.init(M, D, G, bx);
      pg8::EpiPlainBf16 E{ST, D};
      pg8::gemm_phase<pg8::EpiPlainBf16, pg8::StaticOrder, true, true>(lds + RING_OFF, g, S, E, wave); }
    GRID_BAR();
    if (PHMASK & 2048) { pg8::Gemm g{HB, WPGT, M, D, D}; pg8::StaticOrder S; S.init(M, D, G, bx);
      pg8::EpiPle E{out, out, ST, PARTB, PARTA, D};
      pg8::gemm_phase<pg8::EpiPle, pg8::StaticOrder, true, true>(lds + RING_OFF, g, S, E, wave); }
    GRID_BAR();
    if (PHMASK & 4096) {
        PHASE_TID();
        const bool bad = xb_ld((unsigned*)(ctl + CW_BAR) + XB_TMO) != 0u; const float qn = __builtin_nanf("");
        for (int m = gw; m < M; m += NGW) {
            const float rs = pg8::rstd_from_part(PARTA, m);
            GAS f32x4* orow = (GAS f32x4*)(out + (size_t)m * D) + lane; const GAS f32x4* gf = (const GAS f32x4*)g_final + lane;
#pragma unroll
            for (int j = 0; j < 4; ++j) { f32x4 v = orow[64 * j] * rs * gf[64 * j]; if (bad) v = (f32x4){qn, qn, qn, qn}; orow[64 * j] = v; }
        }
    }
}

extern "C" void kernel_launch(void* const* d_in, const int* in_sizes, int n_in, void* d_out, int out_size, void* d_ws, size_t ws_size, hipStream_t stream) {
    static int grid = 0;
    if (grid == 0) {
        if (n_in != 21 || in_sizes[0] != M * D || out_size != M * D || ws_size < WS_END) { fprintf(stderr, "kernel_launch: unexpected shapes (n_in %d, in0 %d, out %d, ws %zu); nothing launched\n", n_in, n_in > 0 ? in_sizes[0] : -1, out_size, ws_size); grid = -1; return; }
        int dev = 0, cus = 0, per_cu = 0;
        if (hipGetDevice(&dev) != hipSuccess || hipDeviceGetAttribute(&cus, hipDeviceAttributeMultiprocessorCount, dev) != hipSuccess) { fprintf(stderr, "kernel_launch: device query failed\n"); grid = -1; return; }
        if (hipFuncSetAttribute((const void*)hymba_fwd, hipFuncAttributeMaxDynamicSharedMemorySize, LDS_BYTES) != hipSuccess) { fprintf(stderr, "kernel_launch: hipFuncSetAttribute failed\n"); grid = -1; return; }
        if (hipOccupancyMaxActiveBlocksPerMultiprocessor(&per_cu, (const void*)hymba_fwd, NWAVES * 64, LDS_BYTES) != hipSuccess || per_cu < 1) { fprintf(stderr, "kernel_launch: occupancy query says %d blocks per CU\n", per_cu); per_cu = 1; }
        (void)hipGetLastError();
        grid = cus;
    }
    if (grid < 0) return;
    if (hipMemsetAsync((char*)d_ws + WS_CTL, 0, CTL_ZERO_BYTES, stream) != hipSuccess) { fprintf(stderr, "kernel_launch: memset failed\n"); return; }
    KArgs a{};
    for (int i = 0; i < 21; ++i) a.in[i] = (const float*)d_in[i];
    a.out = (float*)d_out; a.ws = (unsigned char*)d_ws;
    hipLaunchKernelGGL(hymba_fwd, dim3(grid), dim3(NWAVES * 64), LDS_BYTES, stream, a);
    const hipError_t le = hipPeekAtLastError();
    if (le != hipSuccess) fprintf(stderr, "kernel_launch: launch failed: %s\n", hipGetErrorName(le));
}
```

```cpp
#include <hip/hip_runtime.h>
#include <cstdio>
#include <cstdint>
namespace pg8 {
#define PG8_LAS __attribute__((address_space(3)))
typedef unsigned short bf16_t;
typedef short bf16x8 __attribute__((ext_vector_type(8)));
typedef float f32x4 __attribute__((ext_vector_type(4)));
typedef float f32x2 __attribute__((ext_vector_type(2)));
typedef unsigned u32x4 __attribute__((ext_vector_type(4)));
typedef unsigned u32x2 __attribute__((ext_vector_type(2)));
constexpr int BM = 256, BK = 64, HALF = 128, HTB = HALF * BK * 2  , STAGE_BYTES = 8 * HTB, NXCD = 8, WGM = 8;

__host__ __device__ __forceinline__ int lds_byte(int r, int c) { const int st = (r >> 4) * 2 + (c >> 5), rr = r & 15, cc = c & 31, ob = rr * 64 + cc * 2; return st * 1024 + (ob ^ (((ob >> 9) & 1) << 5)); }
__host__ __device__ __forceinline__ void stage_rc(int b, int& R, int& C) { const int st = b / 1024, sb = b % 1024, swz = sb ^ (((sb >> 9) & 1) << 5); R = (st >> 1) * 16 + swz / 64; C = (st & 1) * 32 + (swz % 64) / 2; }
__host__ __device__ __forceinline__ int perm32(int rho) { const int n = rho >> 4, i = rho & 15; return 8 * (i >> 2) + 4 * n + (i & 3); }

struct Unit { int pm, pn; };
struct Gemm { const bf16_t* A; const bf16_t* Bt; int M, N, K; };

struct StaticOrder {
    int nM, nN, nwg, G, c;
    __host__ __device__ void init(int M, int N, int G_, int c_) { nM = M / BM; nN = N / BM; nwg = nM * nN; G = G_; c = c_; }
    __host__ __device__ bool next(int i, Unit& u) const {
        const long L = (long)i * G + c; if (L >= nwg) return false;
        int wgid = (int)L; { const int q = nwg / NXCD, r = nwg % NXCD, xcd = wgid % NXCD, off = wgid / NXCD; wgid = (xcd < r ? xcd * (q + 1) : r * (q + 1) + (xcd - r) * q) + off; }
        const int nig = WGM * nN, gid = wgid / nig, fm = gid * WGM, gsz = (nM - fm) < WGM ? (nM - fm) : WGM;
        u.pm = fm + ((wgid % nig) % gsz); u.pn = (wgid % nig) / gsz; return true;
    }
    __device__ __forceinline__ void a_ready(const Unit&) const {}
    __device__ __forceinline__ void done(const Unit&) const {}
};

typedef __bf16 bf16x2v __attribute__((ext_vector_type(2)));
__device__ __forceinline__ unsigned cvt_pk_bf16(float lo, float hi) { f32x2 v = {lo, hi}; bf16x2v b = __builtin_convertvector(v, bf16x2v); return __builtin_bit_cast(unsigned, b); }
__device__ __forceinline__ float bf_lo(unsigned w) { return __uint_as_float(w << 16); }
__device__ __forceinline__ float bf_hi(unsigned w) { return __uint_as_float(w & 0xffff0000u); }
__device__ __forceinline__ float fast_sigmoid(float x) { return __builtin_amdgcn_rcpf(1.0f + __expf(-x)); }
constexpr float RMS_EPS = 1e-6f;
__device__ __forceinline__ float rstd_from_part(const float* part, int row) {
    const f32x4* p = (const f32x4*)(part + (size_t)row * 16);
    const f32x4 a = p[0], b = p[1], c = p[2], d = p[3];
    const float s = (((a[0] + a[1]) + (a[2] + a[3])) + ((b[0] + b[1]) + (b[2] + b[3]))) + (((c[0] + c[1]) + (c[2] + c[3])) + ((d[0] + d[1]) + (d[2] + d[3])));
    return 1.0f / sqrtf(s * (1.0f / 1024.0f) + RMS_EPS);
}

struct EpiSwiGLU {
    static constexpr bool PERM = true, AFTER_DRAIN = false;
    bf16_t* O; int ldc; const float* part;
    __device__ __forceinline__ void operator()(const f32x4 (&acc)[2][2][4][2], const Unit& u, int wr, int wc, int fr, int fq) const {
        const int row0 = u.pm * BM + wr * 64 + fr, col0 = u.pn * HALF + wc * 32 + 8 * fq;
#pragma unroll
        for (int ai = 0; ai < 2; ++ai)
#pragma unroll
            for (int m = 0; m < 4; ++m) { const int row = row0 + ai * HALF + m * 16; const float rs = rstd_from_part(part, row);
                float o[8];
#pragma unroll
                for (int n = 0; n < 2; ++n)
#pragma unroll
                    for (int e = 0; e < 4; ++e) { const float g = acc[ai][0][m][n][e] * rs, up = acc[ai][1][m][n][e] * rs; o[4 * n + e] = g * fast_sigmoid(g) * up; }
                u32x4 w; w.x = cvt_pk_bf16(o[0], o[1]); w.y = cvt_pk_bf16(o[2], o[3]); w.z = cvt_pk_bf16(o[4], o[5]); w.w = cvt_pk_bf16(o[6], o[7]);
                *(u32x4*)(O + (size_t)row * ldc + col0) = w; }
    }
};
struct EpiPlainBf16 {
    static constexpr bool PERM = true, AFTER_DRAIN = false;
    bf16_t* O; int ldc;
    __device__ __forceinline__ void operator()(const f32x4 (&acc)[2][2][4][2], const Unit& u, int wr, int wc, int fr, int fq) const {
        const int row0 = u.pm * BM + wr * 64 + fr, col0 = u.pn * BM + wc * 32 + 8 * fq;
#pragma unroll
        for (int ai = 0; ai < 2; ++ai)
#pragma unroll
            for (int m = 0; m < 4; ++m) { bf16_t* rowp = O + (size_t)(row0 + ai * HALF + m * 16) * ldc + col0;
#pragma unroll
                for (int bj = 0; bj < 2; ++bj) { const f32x4 v0 = acc[ai][bj][m][0], v1 = acc[ai][bj][m][1];
                    u32x4 w; w.x = cvt_pk_bf16(v0[0], v0[1]); w.y = cvt_pk_bf16(v0[2], v0[3]); w.z = cvt_pk_bf16(v1[0], v1[1]); w.w = cvt_pk_bf16(v1[2], v1[3]);
                    *(u32x4*)(rowp + bj * HALF) = w; } }
    }
};
struct EpiResid {
    static constexpr bool PERM = false, AFTER_DRAIN = false;
    const float* base; float* out; bf16_t* ob; float* part; float alpha; int ldc;
    __device__ __forceinline__ void operator()(const f32x4 (&acc)[2][2][4][2], const Unit& u, int wr, int wc, int fr, int fq) const {
        const int row0 = u.pm * BM + wr * 64 + fr, col0 = u.pn * BM + wc * 32 + 4 * fq;
#pragma unroll
        for (int ai = 0; ai < 2; ++ai)
#pragma unroll
            for (int m = 0; m < 4; ++m) { const int row = row0 + ai * HALF + m * 16; const size_t off = (size_t)row * ldc + col0; float ss = 0.f;
#pragma unroll
                for (int bj = 0; bj < 2; ++bj)
#pragma unroll
                    for (int n = 0; n < 2; ++n) { const size_t o2 = off + bj * HALF + n * 16; const f32x4 b = *(const f32x4*)(base + o2); const f32x4 v = b + acc[ai][bj][m][n] * alpha;
                        *(f32x4*)(out + o2) = v; u32x2 w; w.x = cvt_pk_bf16(v[0], v[1]); w.y = cvt_pk_bf16(v[2], v[3]); *(u32x2*)(ob + o2) = w;
                        ss += (v[0] * v[0] + v[1] * v[1]) + (v[2] * v[2] + v[3] * v[3]); }
                ss += __shfl_xor(ss, 16); ss += __shfl_xor(ss, 32);
                if (fq == 0) part[(size_t)row * 16 + u.pn * 4 + wc] = ss; }
    }
};
struct EpiPle {
    static constexpr bool PERM = false, AFTER_DRAIN = false;
    const float* base; float* out; const bf16_t* proj; const float* part_in; float* part_out; int ldc;
    __device__ __forceinline__ void operator()(const f32x4 (&acc)[2][2][4][2], const Unit& u, int wr, int wc, int fr, int fq) const {
        const int row0 = u.pm * BM + wr * 64 + fr, col0 = u.pn * BM + wc * 32 + 4 * fq;
#pragma unroll
        for (int ai = 0; ai < 2; ++ai)
#pragma unroll
            for (int m = 0; m < 4; ++m) { const int row = row0 + ai * HALF + m * 16; const size_t off = (size_t)row * ldc + col0; float ss = 0.f; const float rs = rstd_from_part(part_in, row);
#pragma unroll
                for (int bj = 0; bj < 2; ++bj)
#pragma unroll
                    for (int n = 0; n < 2; ++n) { const size_t o2 = off + bj * HALF + n * 16; const f32x4 b = *(const f32x4*)(base + o2); const u32x2 pw = *(const u32x2*)(proj + o2);
                        const f32x4 a = acc[ai][bj][m][n] * rs; f32x4 v;
                        v[0] = b[0] + fast_sigmoid(a[0]) * bf_lo(pw.x); v[1] = b[1] + fast_sigmoid(a[1]) * bf_hi(pw.x); v[2] = b[2] + fast_sigmoid(a[2]) * bf_lo(pw.y); v[3] = b[3] + fast_sigmoid(a[3]) * bf_hi(pw.y);
                        *(f32x4*)(out + o2) = v; ss += (v[0] * v[0] + v[1] * v[1]) + (v[2] * v[2] + v[3] * v[3]); }
                ss += __shfl_xor(ss, 16); ss += __shfl_xor(ss, 32);
                if (fq == 0) part_out[(size_t)row * 16 + u.pn * 4 + wc] = ss; }
    }
};
struct EpiZ {
    static constexpr bool PERM = true, AFTER_DRAIN = false;
    bf16_t* Z; float* GLR; const float* part; const float* COS; const float* SIN;
    __device__ __forceinline__ void operator()(const f32x4 (&acc)[2][2][4][2], const Unit& u, int wr, int wc, int fr, int fq) const {
        const int row0 = u.pm * BM + wr * 64 + fr, pn = u.pn;
        const bool is_rope = (pn == 6 || pn == 7), is_silu = (pn == 4 || pn == 5 || pn == 10 || pn == 11), is_glr = (pn == 12);
        const float sc = (pn == 0 || pn == 6) ? 0.125f : 1.0f;
#pragma unroll
        for (int ai = 0; ai < 2; ++ai)
#pragma unroll
            for (int m = 0; m < 4; ++m) { const int row = row0 + ai * HALF + m * 16; const float rs = rstd_from_part(part, row) * sc;
                if (is_glr) {
                    if (wc == 0 && fq < 2) { *(f32x4*)(GLR + (size_t)row * 16 + 8 * fq) = acc[ai][0][m][0] * rs; *(f32x4*)(GLR + (size_t)row * 16 + 8 * fq + 4) = acc[ai][0][m][1] * rs; }
                } else if (is_rope) {
                    const int pos = row & 4095; const float* cp = COS + pos * 32 + 8 * fq; const float* sp = SIN + pos * 32 + 8 * fq;
                    float o1[8], o2[8];
#pragma unroll
                    for (int n = 0; n < 2; ++n) { const f32x4 c = *(const f32x4*)(cp + 4 * n), s = *(const f32x4*)(sp + 4 * n);
#pragma unroll
                        for (int e = 0; e < 4; ++e) { const float t1 = acc[ai][0][m][n][e] * rs, t2 = acc[ai][1][m][n][e] * rs; o1[4 * n + e] = t1 * c[e] - t2 * s[e]; o2[4 * n + e] = t2 * c[e] + t1 * s[e]; } }
                    bf16_t* rowp = Z + (size_t)row * 3072 + pn * BM + wc * 64 + 8 * fq;
                    u32x4 w; w.x = cvt_pk_bf16(o1[0], o1[1]); w.y = cvt_pk_bf16(o1[2], o1[3]); w.z = cvt_pk_bf16(o1[4], o1[5]); w.w = cvt_pk_bf16(o1[6], o1[7]); *(u32x4*)rowp = w;
                    w.x = cvt_pk_bf16(o2[0], o2[1]); w.y = cvt_pk_bf16(o2[2], o2[3]); w.z = cvt_pk_bf16(o2[4], o2[5]); w.w = cvt_pk_bf16(o2[6], o2[7]); *(u32x4*)(rowp + 32) = w;
                } else {
                    bf16_t* rowp = Z + (size_t)row * 3072 + pn * BM + wc * 32 + 8 * fq;
#pragma unroll
                    for (int bj = 0; bj < 2; ++bj) { f32x4 v0 = acc[ai][bj][m][0] * rs, v1 = acc[ai][bj][m][1] * rs;
                        if (is_silu) {
#pragma unroll
                            for (int e = 0; e < 4; ++e) { v0[e] = v0[e] * fast_sigmoid(v0[e]); v1[e] = v1[e] * fast_sigmoid(v1[e]); } }
                        u32x4 w; w.x = cvt_pk_bf16(v0[0], v0[1]); w.y = cvt_pk_bf16(v0[2], v0[3]); w.z = cvt_pk_bf16(v1[0], v1[1]); w.w = cvt_pk_bf16(v1[2], v1[3]);
                        *(u32x4*)(rowp + bj * HALF) = w; }
                } }
    }
};
template <class Epi, class Sched, bool ALIGN_EPI = false, bool SP2 = false>
__device__ __forceinline__ void gemm_phase(PG8_LAS unsigned char* lds, const Gemm g, const Sched& S, const Epi& E, const int wave_id) {
    int tid_ = wave_id * 64 + (int)__builtin_amdgcn_mbcnt_hi(~0u, __builtin_amdgcn_mbcnt_lo(~0u, 0u)); asm volatile("" : "+v"(tid_));
    const int tid = tid_, wid = __builtin_amdgcn_readfirstlane(tid >> 6), lane = tid & 63, wr = wid >> 2, wc = wid & 3, fr = lane & 15, fq = lane >> 4;
    const int K = g.K, nt = K / BK;
    unsigned voffA[2], voffB[2];
#pragma unroll
    for (int i = 0; i < 2; ++i) { int R, C; stage_rc(tid * 16 + i * 8192, R, C); const int Rb = Epi::PERM ? ((R & ~31) + perm32(R & 31)) : R;
        voffA[i] = (unsigned)(R * K + C) * 2u; voffB[i] = (unsigned)(Rb * K + C) * 2u; }
    const size_t kstep = (size_t)(BK * 2);
    const size_t hstep = (size_t)HALF * K * 2;
    const size_t tstep = 2 * hstep;
    const unsigned ldsw = (unsigned)wid * 1024u;
    const int aoff = lds_byte(wr * 64 + fr, fq * 8), boff = lds_byte(wc * 32 + fr, fq * 8);
#define PG8_SA(b, h) (((b) * 2 + (h)) * HTB)
#define PG8_SB(b, h) ((4 + (b) * 2 + (h)) * HTB)
#define PG8_STAGE(bufoff, gbase, voff) do { _Pragma("unroll") for (int _i = 0; _i < 2; ++_i) \
        __builtin_amdgcn_global_load_lds((const unsigned*)((const char*)(gbase) + (voff)[_i]), (PG8_LAS unsigned*)(lds + (bufoff) + ldsw + _i * 8192), 16, 0, 0); } while (0)
#define PG8_LDA(dst, b, h) do { _Pragma("unroll") for (int m = 0; m < 4; ++m) _Pragma("unroll") for (int k = 0; k < 2; ++k) dst[m][k] = *(const PG8_LAS bf16x8*)(lds + PG8_SA(b, h) + aoff + m * 2048 + k * 1024); } while (0)
#define PG8_LDB(dst, b, h) do { _Pragma("unroll") for (int n = 0; n < 2; ++n) _Pragma("unroll") for (int k = 0; k < 2; ++k) dst[n][k] = *(const PG8_LAS bf16x8*)(lds + PG8_SB(b, h) + boff + n * 2048 + k * 1024); } while (0)
#define PG8_MMA(ai, bj, At, Bt) do { __builtin_amdgcn_s_setprio(1); _Pragma("unroll") for (int m = 0; m < 4; ++m) _Pragma("unroll") for (int n = 0; n < 2; ++n) _Pragma("unroll") for (int k = 0; k < 2; ++k) \
        acc[ai][bj][m][n] = __builtin_amdgcn_mfma_f32_16x16x32_bf16(Bt[n][k], At[m][k], acc[ai][bj][m][n], 0, 0, 0); __builtin_amdgcn_s_setprio(0); } while (0)
#define PG8_WAIT_V(n) asm volatile("s_waitcnt vmcnt(" #n ")" ::: "memory")
#define PG8_WAIT_L(n) asm volatile("s_waitcnt lgkmcnt(" #n ")" ::: "memory")
#define PG8_BAR __builtin_amdgcn_s_barrier()
#define PG8_SCHED __builtin_amdgcn_sched_barrier(0)
    Unit cur, nxt; int ui = 0;
    if (!S.next(0, cur)) return;
    f32x4 acc[2][2][4][2];
#pragma unroll
    for (int a = 0; a < 2; ++a)
#pragma unroll
        for (int b = 0; b < 2; ++b)
#pragma unroll
            for (int m = 0; m < 4; ++m)
#pragma unroll
                for (int n = 0; n < 2; ++n) acc[a][b][m][n] = (f32x4){0.f, 0.f, 0.f, 0.f};
    bf16x8 At[4][2], B0[2][2], B1[2][2];
    const char* cA = (const char*)g.A + (size_t)cur.pm * tstep; const char* cB = (const char*)g.Bt + (size_t)cur.pn * tstep;
    S.a_ready(cur);
    if constexpr (SP2) {
        PG8_STAGE(PG8_SB(0, 0), cB, voffB); PG8_STAGE(PG8_SB(0, 1), cB + hstep, voffB); PG8_STAGE(PG8_SA(0, 0), cA, voffA); PG8_STAGE(PG8_SA(0, 1), cA + hstep, voffA);
        if (wr == 1) PG8_BAR;
        PG8_WAIT_V(2); PG8_BAR;
        PG8_STAGE(PG8_SB(1, 0), cB + kstep, voffB); PG8_STAGE(PG8_SA(1, 0), cA + kstep, voffA); PG8_STAGE(PG8_SB(1, 1), cB + hstep + kstep, voffB);
        PG8_WAIT_V(6); PG8_BAR;
    } else {
        PG8_STAGE(PG8_SB(0, 0), cB, voffB); PG8_STAGE(PG8_SA(0, 0), cA, voffA); PG8_STAGE(PG8_SB(0, 1), cB + hstep, voffB); PG8_STAGE(PG8_SA(0, 1), cA + hstep, voffA);
        if (wr == 1) PG8_BAR;
        PG8_WAIT_V(4); PG8_BAR;
        PG8_STAGE(PG8_SB(1, 0), cB + kstep, voffB); PG8_STAGE(PG8_SA(1, 0), cA + kstep, voffA); PG8_STAGE(PG8_SB(1, 1), cB + hstep + kstep, voffB);
        PG8_WAIT_V(6); PG8_BAR;
    }
    for (;;) {
        const bool has_next = S.next(ui + 1, nxt);
        const char* nA = has_next ? (const char*)g.A + (size_t)nxt.pm * tstep : cA; const char* nB = has_next ? (const char*)g.Bt + (size_t)nxt.pn * tstep : cB;
        _Pragma("unroll 1") for (int t = 0; t < nt; t += 2) {
            const bool last = (t == nt - 2);
            const char* a1 = cA + (size_t)(t + 1) * kstep;
            const char* a2 = last ? nA : cA + (size_t)(t + 2) * kstep; const char* b2 = last ? nB : cB + (size_t)(t + 2) * kstep;
            const char* a3 = a2 + kstep; const char* b3 = b2 + kstep;
            if (last && has_next) S.a_ready(nxt);
            if constexpr (SP2) {
            PG8_LDB(B0, 0, 0); PG8_LDB(B1, 0, 1); PG8_SCHED; PG8_LDA(At, 0, 0); PG8_STAGE(PG8_SA(1, 1), a1 + hstep, voffA);
            PG8_WAIT_V(8); PG8_WAIT_L(0); PG8_BAR; PG8_MMA(0, 0, At, B0); PG8_MMA(0, 1, At, B1); PG8_BAR; PG8_SCHED;
            PG8_LDA(At, 0, 1); PG8_STAGE(PG8_SB(0, 0), b2, voffB); PG8_STAGE(PG8_SB(0, 1), b2 + hstep, voffB); PG8_STAGE(PG8_SA(0, 0), a2, voffA);
            PG8_WAIT_V(8); PG8_WAIT_L(0); PG8_BAR; PG8_MMA(1, 0, At, B0); PG8_MMA(1, 1, At, B1); PG8_BAR; PG8_SCHED;
            PG8_LDB(B0, 1, 0); PG8_LDB(B1, 1, 1); PG8_SCHED; PG8_LDA(At, 1, 0); PG8_STAGE(PG8_SA(0, 1), a2 + hstep, voffA);
            PG8_WAIT_V(8); PG8_WAIT_L(0); PG8_BAR; PG8_MMA(0, 0, At, B0); PG8_MMA(0, 1, At, B1); PG8_BAR; PG8_SCHED;
            PG8_LDA(At, 1, 1); PG8_STAGE(PG8_SB(1, 0), b3, voffB); PG8_STAGE(PG8_SB(1, 1), b3 + hstep, voffB); PG8_STAGE(PG8_SA(1, 0), a3, voffA);
            PG8_WAIT_V(8); PG8_WAIT_L(0); PG8_BAR; PG8_MMA(1, 0, At, B0); PG8_MMA(1, 1, At, B1); PG8_BAR; PG8_SCHED;
            } else {
            PG8_LDB(B0, 0, 0); PG8_SCHED; PG8_LDA(At, 0, 0); PG8_STAGE(PG8_SA(1, 1), a1 + hstep, voffA);
            PG8_WAIT_L(8); PG8_BAR; PG8_WAIT_L(0); PG8_MMA(0, 0, At, B0); PG8_BAR; PG8_SCHED;
            PG8_LDB(B1, 0, 1); PG8_STAGE(PG8_SB(0, 0), b2, voffB);
            PG8_BAR; PG8_WAIT_L(0); PG8_MMA(0, 1, At, B1); PG8_BAR;
            PG8_LDA(At, 0, 1); PG8_STAGE(PG8_SA(0, 0), a2, voffA);
            PG8_BAR; PG8_WAIT_L(0); PG8_MMA(1, 0, At, B0); PG8_BAR; PG8_SCHED;
            PG8_STAGE(PG8_SB(0, 1), b2 + hstep, voffB);
            PG8_WAIT_V(6); PG8_BAR; PG8_MMA(1, 1, At, B1); PG8_BAR;
            PG8_LDB(B0, 1, 0); PG8_SCHED; PG8_LDA(At, 1, 0); PG8_STAGE(PG8_SA(0, 1), a2 + hstep, voffA);
            PG8_WAIT_L(8); PG8_BAR; PG8_WAIT_L(0); PG8_MMA(0, 0, At, B0); PG8_BAR; PG8_SCHED;
            PG8_LDB(B1, 1, 1); PG8_STAGE(PG8_SB(1, 0), b3, voffB);
            PG8_BAR; PG8_WAIT_L(0); PG8_MMA(0, 1, At, B1); PG8_BAR;
            PG8_LDA(At, 1, 1); PG8_STAGE(PG8_SA(1, 0), a3, voffA);
            PG8_BAR; PG8_WAIT_L(0); PG8_MMA(1, 0, At, B0); PG8_BAR; PG8_SCHED;
            PG8_STAGE(PG8_SB(1, 1), b3 + hstep, voffB);
            PG8_WAIT_V(6); PG8_BAR; PG8_MMA(1, 1, At, B1); PG8_BAR;
            }
        }
        if constexpr (ALIGN_EPI) { if (wr == 0) PG8_BAR; }
        if constexpr (!Epi::AFTER_DRAIN) { E(acc, cur, wr, wc, fr, fq); S.done(cur); }
        if (!has_next) break;
#pragma unroll
        for (int a = 0; a < 2; ++a)
#pragma unroll
            for (int b = 0; b < 2; ++b)
#pragma unroll
                for (int m = 0; m < 4; ++m)
#pragma unroll
                    for (int n = 0; n < 2; ++n) acc[a][b][m][n] = (f32x4){0.f, 0.f, 0.f, 0.f};
        cur = nxt; cA = nA; cB = nB; ++ui;
        if constexpr (ALIGN_EPI) { if (wr == 1) PG8_BAR; }
    }
    PG8_WAIT_V(0);
    if constexpr (!ALIGN_EPI) { if (wr == 0) PG8_BAR; }
    PG8_BAR;
    if constexpr (Epi::AFTER_DRAIN) { E.fused(acc, cur, wr, wc, fr, fq, lds, wid, lane); S.done(cur); }
#undef PG8_SA
#undef PG8_SB
#undef PG8_STAGE
#undef PG8_LDA
#undef PG8_LDB
#undef PG8_MMA
#undef PG8_WAIT_V
#undef PG8_WAIT_L
#undef PG8_BAR
#undef PG8_SCHED
}
}

namespace mix {
#define MIX_LAS __attribute__((address_space(3)))
typedef unsigned short bf16_t;
typedef short bf16x8 __attribute__((ext_vector_type(8)));
typedef short s16x4 __attribute__((ext_vector_type(4)));
typedef float f32x4 __attribute__((ext_vector_type(4)));
typedef float f32x2 __attribute__((ext_vector_type(2)));
typedef float f32x16 __attribute__((ext_vector_type(16)));
typedef unsigned u32x4 __attribute__((ext_vector_type(4)));
typedef unsigned u32x2 __attribute__((ext_vector_type(2)));
typedef MIX_LAS unsigned char* ldsp;
constexpr int ZP = 3072;
constexpr int ZC_GQ = 0, ZC_GK = 256, ZC_GV = 512, ZC_GR = 1024, ZC_RQ = 1536, ZC_RK = 1792, ZC_RV = 2048, ZC_RG = 2560;
constexpr int SEQ = 4096, NCH = 64;
#define MFMA32(a, b, c) __builtin_amdgcn_mfma_f32_32x32x16_bf16((a), (b), (c), 0, 0, 0)
#define MFMA32F(a, b, c) __builtin_amdgcn_mfma_f32_32x32x2f32((a), (b), (c), 0, 0, 0)
__device__ __forceinline__ int crow(int r, int h) { return (r & 3) + 8 * (r >> 2) + 4 * h; }
__device__ __forceinline__ unsigned pk2(float lo, float hi) { return pg8::cvt_pk_bf16(lo, hi); }
__device__ __forceinline__ float lo16(unsigned w) { return __uint_as_float(w << 16); }
__device__ __forceinline__ float hi16(unsigned w) { return __uint_as_float(w & 0xffff0000u); }
__device__ __forceinline__ bf16x8 mk8(u32x2 lo, u32x2 hi) { u32x4 v; v.x = lo.x; v.y = lo.y; v.z = hi.x; v.w = hi.y; return __builtin_bit_cast(bf16x8, v); }
__device__ __forceinline__ void ld_dfrag(const bf16_t* rowp, int ks, int h, u32x2& lo, u32x2& hi) { lo = *(const u32x2*)(rowp + 16 * ks + 4 * h); hi = *(const u32x2*)(rowp + 16 * ks + 8 + 4 * h); }
__device__ __forceinline__ bf16x8 scale8(u32x2 lo, u32x2 hi, const float (&f)[8]) {
    u32x4 v; v.x = pk2(lo16(lo.x) * f[0], hi16(lo.x) * f[1]); v.y = pk2(lo16(lo.y) * f[2], hi16(lo.y) * f[3]); v.z = pk2(lo16(hi.x) * f[4], hi16(hi.x) * f[5]); v.w = pk2(lo16(hi.y) * f[6], hi16(hi.y) * f[7]);
    return __builtin_bit_cast(bf16x8, v);
}
__device__ __forceinline__ bf16x8 scale8s(u32x2 lo, u32x2 hi, float f) {
    u32x4 v; v.x = pk2(lo16(lo.x) * f, hi16(lo.x) * f); v.y = pk2(lo16(lo.y) * f, hi16(lo.y) * f); v.z = pk2(lo16(hi.x) * f, hi16(hi.x) * f); v.w = pk2(lo16(hi.y) * f, hi16(hi.y) * f);
    return __builtin_bit_cast(bf16x8, v);
}
__device__ __forceinline__ bf16x8 pack_step(const f32x16& x, int s) {
    u32x4 v; v.x = pk2(x[8 * s], x[8 * s + 1]); v.y = pk2(x[8 * s + 2], x[8 * s + 3]); v.z = pk2(x[8 * s + 4], x[8 * s + 5]); v.w = pk2(x[8 * s + 6], x[8 * s + 7]);
    return __builtin_bit_cast(bf16x8, v);
}
typedef short v4i16_t __attribute__((ext_vector_type(4)));
__device__ __forceinline__ s16x4 tr4(ldsp p) { return __builtin_bit_cast(s16x4, __builtin_amdgcn_ds_read_tr16_b64_v4i16((MIX_LAS v4i16_t*)p)); }
__device__ __forceinline__ bf16x8 tr_frag(ldsp tile, int RS, int rb0, int rb1, int cb, int lane) {
    const int q = (lane & 15) >> 2, p = lane & 3, blk = (lane >> 4) & 1; const int coff = (cb + 16 * blk + 4 * p) * 2;
    const s16x4 a = tr4(tile + (rb0 + q) * RS + coff), b = tr4(tile + (rb1 + q) * RS + coff);
    return (bf16x8){a[0], a[1], a[2], a[3], b[0], b[1], b[2], b[3]};
}
template <int NC> __device__ __forceinline__ void tile_to_lds(const bf16_t* g, ldsp tile, int lane) {
    constexpr int CPR = NC / 8, RPS = 64 / CPR;
    const bf16_t* gb = g + (size_t)(lane / CPR) * ZP + (lane % CPR) * 8; const ldsp lb = tile + (lane / CPR) * (NC * 2) + (lane % CPR) * 16;
#pragma unroll
    for (int i = 0; i < CPR; ++i) { const u32x4 v = *(const u32x4*)(gb + (size_t)i * RPS * ZP); *(MIX_LAS u32x4*)(lb + i * RPS * (NC * 2)) = v; }
}
__device__ __forceinline__ float ret_log_gamma(int hd) { return logf(1.0f - exp2f(-5.0f - (float)hd)); }

__device__ __forceinline__ void gla_cum(f32x16 (&L)[2][2], const float* wgu, const float* bias, const float* glr, int row0, int hd, int lane) {
    const int c = lane & 31, h = lane >> 5;
#pragma unroll
    for (int cd = 0; cd < 2; ++cd)
#pragma unroll
        for (int g = 0; g < 4; ++g) { const f32x4 bv = *(const f32x4*)(bias + hd * 64 + 32 * cd + 8 * g + 4 * h);
#pragma unroll
            for (int e = 0; e < 4; ++e) { L[cd][0][4 * g + e] = bv[e]; L[cd][1][4 * g + e] = bv[e]; } }
#pragma unroll
    for (int kk = 0; kk < 8; ++kk) {
        const float a0 = wgu[(2 * kk + h) * 256 + hd * 64 + c], a1 = wgu[(2 * kk + h) * 256 + hd * 64 + 32 + c];
        const float b0 = glr[(size_t)(row0 + c) * 16 + 2 * kk + h], b1 = glr[(size_t)(row0 + 32 + c) * 16 + 2 * kk + h];
        L[0][0] = MFMA32F(a0, b0, L[0][0]); L[0][1] = MFMA32F(a0, b1, L[0][1]); L[1][0] = MFMA32F(a1, b0, L[1][0]); L[1][1] = MFMA32F(a1, b1, L[1][1]);
    }
#pragma unroll
    for (int cd = 0; cd < 2; ++cd)
#pragma unroll
        for (int r = 0; r < 16; ++r) {
            float x0 = L[cd][0][r], x1 = L[cd][1][r];
            x0 = (fminf(x0, 0.f) - __logf(1.0f + __expf(-fabsf(x0)))) * 0.0625f; x1 = (fminf(x1, 0.f) - __logf(1.0f + __expf(-fabsf(x1)))) * 0.0625f;
#pragma unroll
            for (int s = 1; s < 32; s <<= 1) { const float y0 = __shfl_up(x0, s, 32), y1 = __shfl_up(x1, s, 32); if (c >= s) { x0 += y0; x1 += y1; } }
            x1 += __shfl(x0, 31, 32);
            L[cd][0][r] = x0; L[cd][1][r] = x1;
        }
}

struct MixPtrs {
    const bf16_t* Z; const float* GLR; bf16_t* ST; float* DEC; float* CUM; bf16_t* Y;
    const float* wgu; const float* bgate; const float* g_gla; const float* g_ret;
};

template <int KIND> __device__ __forceinline__ void m1_unit(const MixPtrs& P, int u, ldsp lds, int lane) {
    asm volatile("" : "+v"(lane));
    const int c = lane & 31, h = lane >> 5;
    const int n = u & 63, hd = (u >> 6) & 3, b = u >> 8, row0 = b * SEQ + n * 64, gh = KIND * 16 + b * 4 + hd;
    const ldsp Kt = lds, Vt = lds + 8192;
    const bf16_t* zk = P.Z + (size_t)row0 * ZP + (KIND == 0 ? ZC_GK : ZC_RK) + hd * 64;
    if (KIND == 0) {
        f32x16 L[2][2]; gla_cum(L, P.wgu, P.bgate, P.GLR, row0, hd, lane);
#pragma unroll
        for (int t = 0; t < 2; ++t) { float* cp = P.CUM + (size_t)u * 4096 + t * 2048 + lane * 32;
#pragma unroll
            for (int cd = 0; cd < 2; ++cd)
#pragma unroll
                for (int s = 0; s < 2; ++s) {
                    *(f32x4*)(cp + (cd * 2 + s) * 8) = (f32x4){L[cd][t][8 * s], L[cd][t][8 * s + 1], L[cd][t][8 * s + 2], L[cd][t][8 * s + 3]};
                    *(f32x4*)(cp + (cd * 2 + s) * 8 + 4) = (f32x4){L[cd][t][8 * s + 4], L[cd][t][8 * s + 5], L[cd][t][8 * s + 6], L[cd][t][8 * s + 7]}; } }
#pragma unroll
        for (int cd = 0; cd < 2; ++cd) {
            f32x16 CL;
#pragma unroll
            for (int r = 0; r < 16; ++r) CL[r] = __shfl(L[cd][1][r], 31, 32);
            if (c == 0) {
#pragma unroll
                for (int r = 0; r < 16; ++r) P.DEC[(size_t)u * 64 + 32 * cd + crow(r, h)] = __expf(CL[r]); }
#pragma unroll
            for (int t = 0; t < 2; ++t)
#pragma unroll
                for (int s = 0; s < 2; ++s) { const int ks = 2 * cd + s; u32x2 lo, hi; ld_dfrag(zk + (size_t)(32 * t + c) * ZP, ks, h, lo, hi);
                    float f[8];
#pragma unroll
                    for (int jj = 0; jj < 8; ++jj) f[jj] = __expf(CL[8 * s + jj] - L[cd][t][8 * s + jj]);
                    const u32x4 v = __builtin_bit_cast(u32x4, scale8(lo, hi, f));
                    const ldsp kp = Kt + (32 * t + c) * 128 + (16 * ks + 4 * h) * 2;
                    *(MIX_LAS u32x2*)kp = (u32x2){v.x, v.y}; *(MIX_LAS u32x2*)(kp + 16) = (u32x2){v.z, v.w}; }
        }
    } else {
        const float lg = ret_log_gamma(hd);
#pragma unroll
        for (int t = 0; t < 2; ++t) { const float w = __expf(lg * (float)(63 - (32 * t + c)));
#pragma unroll
            for (int ks = 0; ks < 4; ++ks) { u32x2 lo, hi; ld_dfrag(zk + (size_t)(32 * t + c) * ZP, ks, h, lo, hi);
                const u32x4 v = __builtin_bit_cast(u32x4, scale8s(lo, hi, w));
                const ldsp kp = Kt + (32 * t + c) * 128 + (16 * ks + 4 * h) * 2;
                *(MIX_LAS u32x2*)kp = (u32x2){v.x, v.y}; *(MIX_LAS u32x2*)(kp + 16) = (u32x2){v.z, v.w}; } }
    }
    const bf16_t* zv = P.Z + (size_t)row0 * ZP + (KIND == 0 ? ZC_GV : ZC_RV) + hd * 128;
    bf16_t* st = P.ST + ((size_t)gh * NCH + n) * 8192;
#pragma unroll 1
    for (int vh = 0; vh < 2; ++vh) {
        tile_to_lds<64>(zv + vh * 64, Vt, lane);
        f32x16 acc[2][2];
#pragma unroll
        for (int a = 0; a < 2; ++a)
#pragma unroll
            for (int bq = 0; bq < 2; ++bq)
#pragma unroll
                for (int r = 0; r < 16; ++r) acc[a][bq][r] = 0.f;
#pragma unroll
        for (int kj = 0; kj < 4; ++kj) { const int rb = 16 * kj + 8 * h;
            const bf16x8 a0 = tr_frag(Vt, 128, rb, rb + 4, 0, lane), a1 = tr_frag(Vt, 128, rb, rb + 4, 32, lane);
            const bf16x8 b0 = tr_frag(Kt, 128, rb, rb + 4, 0, lane), b1 = tr_frag(Kt, 128, rb, rb + 4, 32, lane);
            acc[0][0] = MFMA32(a0, b0, acc[0][0]); acc[0][1] = MFMA32(a0, b1, acc[0][1]); acc[1][0] = MFMA32(a1, b0, acc[1][0]); acc[1][1] = MFMA32(a1, b1, acc[1][1]); }
#pragma unroll
        for (int cvl = 0; cvl < 2; ++cvl)
#pragma unroll
            for (int cd = 0; cd < 2; ++cd)
#pragma unroll
                for (int r = 0; r < 16; r += 2) {
                    bf16_t* p0 = st + (size_t)(vh * 64 + 32 * cvl + crow(r, h)) * 64 + 32 * cd + c; const unsigned w = pk2(acc[cvl][cd][r], acc[cvl][cd][r + 1]);
                    p0[0] = (bf16_t)(w & 0xffffu); p0[64] = (bf16_t)(w >> 16); }
    }
}

#define MIX_FENCE() asm volatile("" ::: "memory")
template <int KIND> __device__ __forceinline__ void m3_unit(const MixPtrs& P, int u, ldsp lds, int lane) {
    asm volatile("" : "+v"(lane));
    const int c = lane & 31, h = lane >> 5;
    const int n = u & 63, hd = (u >> 6) & 3, b = u >> 8, row0 = b * SEQ + n * 64, gh = KIND * 16 + b * 4 + hd;
    const bf16_t* zq = P.Z + (size_t)row0 * ZP + (KIND == 0 ? ZC_GQ : ZC_RQ) + hd * 64;
    const bf16_t* zk = P.Z + (size_t)row0 * ZP + (KIND == 0 ? ZC_GK : ZC_RK) + hd * 64;
    const bf16_t* zv = P.Z + (size_t)row0 * ZP + (KIND == 0 ? ZC_GV : ZC_RV) + hd * 128;
    const bf16_t* zr = P.Z + (size_t)row0 * ZP + (KIND == 0 ? ZC_GR : ZC_RG) + hd * 128;
    const bf16_t* pt = P.ST + ((size_t)gh * NCH + n) * 8192;
    const float* gn = (KIND == 0 ? P.g_gla : P.g_ret) + hd * 128;
    const float* cum = P.CUM + (size_t)u * 4096 + lane * 32;
    const float lg = ret_log_gamma(hd);
    tile_to_lds<128>(zv, lds, lane);
#pragma unroll 1
    for (int ti = 0; ti < 2; ++ti) {
        const int i = 32 * ti + c;
        bf16x8 qf[4];
        const bf16_t* qrow = zq + (size_t)i * ZP;
#pragma unroll
        for (int ks = 0; ks < 4; ++ks) { u32x2 lo, hi; ld_dfrag(qrow, ks, h, lo, hi);
            if (KIND == 0) { const float* cp = cum + ti * 2048 + ks * 8; const f32x4 c0 = *(const f32x4*)cp, c1 = *(const f32x4*)(cp + 4);
                float fp[8];
#pragma unroll
                for (int e = 0; e < 4; ++e) { fp[e] = __expf(c0[e]); fp[4 + e] = __expf(c1[e]); }
                qf[ks] = scale8(lo, hi, fp);
            } else { qf[ks] = mk8(lo, hi); } }
        MIX_FENCE();
        bf16x8 spk[2][2];
#pragma unroll
        for (int tj = 0; tj < 2; ++tj) {
            f32x16 T;
            const bf16_t* krow = zk + (size_t)(32 * tj + c) * ZP;
            if (KIND == 0) {
                const bool need_f = (tj <= ti), need_b = (tj >= ti);
                f32x16 F, Bw;
#pragma unroll
                for (int r = 0; r < 16; ++r) { F[r] = 0.f; Bw[r] = 0.f; }
                if (need_f) {
#pragma unroll
                    for (int ks = 0; ks < 4; ++ks) { u32x2 lo, hi; ld_dfrag(krow, ks, h, lo, hi);
                        const float* cp = cum + tj * 2048 + ks * 8; const f32x4 c0 = *(const f32x4*)cp, c1 = *(const f32x4*)(cp + 4);
                        float fn[8];
#pragma unroll
                        for (int e = 0; e < 4; ++e) { fn[e] = __expf(-c0[e]); fn[4 + e] = __expf(-c1[e]); }
                        F = MFMA32(scale8(lo, hi, fn), qf[ks], F); if (ks & 1) MIX_FENCE(); } }
                if (need_b) {
#pragma unroll
                    for (int ks = 0; ks < 4; ++ks) { u32x2 lo, hi, ql, qh; ld_dfrag(krow, ks, h, lo, hi); ld_dfrag(qrow, ks, h, ql, qh);
                        const float* cp = cum + tj * 2048 + ks * 8; const f32x4 c0 = *(const f32x4*)cp, c1 = *(const f32x4*)(cp + 4);
                        const float* cq = cum + ti * 2048 + ks * 8; const f32x4 q0 = *(const f32x4*)cq, q1 = *(const f32x4*)(cq + 4);
                        float fp[8], fn[8];
#pragma unroll
                        for (int e = 0; e < 4; ++e) { fp[e] = __expf(c0[e]); fp[4 + e] = __expf(c1[e]); fn[e] = __expf(-q0[e]); fn[4 + e] = __expf(-q1[e]); }
                        Bw = MFMA32(scale8(lo, hi, fp), scale8(ql, qh, fn), Bw); MIX_FENCE(); } }
#pragma unroll
                for (int r = 0; r < 16; ++r) { const int j = 32 * tj + crow(r, h); T[r] = need_f ? ((need_b && i < j) ? Bw[r] : F[r]) : Bw[r]; }
            } else {
#pragma unroll
                for (int r = 0; r < 16; ++r) T[r] = 0.f;
#pragma unroll
                for (int ks = 0; ks < 4; ++ks) { u32x2 lo, hi; ld_dfrag(krow, ks, h, lo, hi); T = MFMA32(mk8(lo, hi), qf[ks], T); }
#pragma unroll
                for (int r = 0; r < 16; ++r) { const int j = 32 * tj + crow(r, h); const int dist = i >= j ? i - j : j - i; T[r] *= __expf(lg * (float)dist); }
            }
            spk[tj][0] = pack_step(T, 0); spk[tj][1] = pack_step(T, 1);
            MIX_FENCE();
        }
        f32x16 acc[4];
#pragma unroll
        for (int cv = 0; cv < 4; ++cv) {
#pragma unroll
            for (int r = 0; r < 16; ++r) acc[cv][r] = 0.f;
#pragma unroll
            for (int ks = 0; ks < 4; ++ks) { u32x2 lo, hi; ld_dfrag(pt + (size_t)(32 * cv + c) * 64, ks, h, lo, hi); acc[cv] = MFMA32(mk8(lo, hi), qf[ks], acc[cv]); }
            MIX_FENCE();
        }
        if (KIND == 1) { const float qd = __expf(lg * (float)(i + 1));
#pragma unroll
            for (int cv = 0; cv < 4; ++cv)
#pragma unroll
                for (int r = 0; r < 16; ++r) acc[cv][r] *= qd; }
#pragma unroll
        for (int cv = 0; cv < 4; ++cv) {
#pragma unroll
            for (int tj = 0; tj < 2; ++tj)
#pragma unroll
                for (int s = 0; s < 2; ++s) { const int rb = 32 * tj + 16 * s + 4 * h; acc[cv] = MFMA32(tr_frag(lds, 256, rb, rb + 8, 32 * cv, lane), spk[tj][s], acc[cv]); }
            MIX_FENCE();
        }
        float ss = 0.f;
#pragma unroll
        for (int cv = 0; cv < 4; ++cv)
#pragma unroll
            for (int r = 0; r < 16; ++r) ss += acc[cv][r] * acc[cv][r];
        ss += __shfl_xor(ss, 32);
        const float rs = 1.0f / sqrtf(ss * (1.0f / 128.0f) + pg8::RMS_EPS);
        bf16_t* yrow = P.Y + (size_t)(row0 + i) * 1024 + KIND * 512 + hd * 128;
        const bf16_t* rrow = zr + (size_t)i * ZP;
#pragma unroll
        for (int cv = 0; cv < 4; ++cv) {
#pragma unroll
            for (int g = 0; g < 4; ++g) { const int v0 = 32 * cv + 8 * g + 4 * h; const f32x4 gv = *(const f32x4*)(gn + v0); const u32x2 rw = *(const u32x2*)(rrow + v0);
                u32x2 w; w.x = pk2(acc[cv][4 * g] * rs * gv[0] * lo16(rw.x), acc[cv][4 * g + 1] * rs * gv[1] * hi16(rw.x));
                w.y = pk2(acc[cv][4 * g + 2] * rs * gv[2] * lo16(rw.y), acc[cv][4 * g + 3] * rs * gv[3] * hi16(rw.y));
                *(u32x2*)(yrow + v0) = w; }
            MIX_FENCE();
        }
    }
}

__device__ __forceinline__ void m2_scan(const MixPtrs& P, int T, int NT) {
    for (int pi = T; pi < 32 * 4096; pi += NT) {
        const int gh = pi >> 12, e = (pi & 4095) * 2, d = e & 63, hd = gh & 3;
        bf16_t* p = P.ST + (size_t)gh * NCH * 8192 + e;
        const bool isg = gh < 16;
        const float ar = __expf(ret_log_gamma(hd) * 64.0f);
        const float* dp = P.DEC + (size_t)(gh & 15) * NCH * 64 + d;
        float s0 = 0.f, s1 = 0.f;
#pragma unroll 8
        for (int n = 0; n < NCH; ++n) {
            const unsigned w = *(const unsigned*)(p + (size_t)n * 8192);
            float a0 = ar, a1 = ar;
            if (isg) { const f32x2 a = *(const f32x2*)(dp + n * 64); a0 = a[0]; a1 = a[1]; }
            *(unsigned*)(p + (size_t)n * 8192) = pk2(s0, s1);
            s0 = a0 * s0 + lo16(w); s1 = a1 * s1 + hi16(w);
        }
    }
}
}

#ifndef PHMASK
#define PHMASK 0xFFFF
#endif
#ifndef DUPMASK
#define DUPMASK 0
#endif
#define REPS(bit) for (int rep_ = 0; rep_ < ((DUPMASK & (bit)) ? 2 : 1); ++rep_)
#define REP_BAR(bit) if ((DUPMASK & (bit)) && rep_ == 1) GRID_BAR()
constexpr int NWAVES = 8;
constexpr int BATCH = 4, SEQ = 4096, D = 1024, FF = 2816, PLE = 256, NZ = 3072  , NZG = 3104  , IN_COLS = 3088;
constexpr int M = BATCH * SEQ;
constexpr size_t MiB = 1u << 20;
constexpr size_t WS_CTL = 0, CTL_ZERO_BYTES = 64 * 1024;
constexpr size_t WS_PARTA = 1 * MiB, WS_PARTB = 2 * MiB;
constexpr size_t WS_GLR = 3 * MiB;
constexpr size_t WS_COS = 4 * MiB, WS_SIN = 4 * MiB + 512 * 1024;
constexpr size_t WS_DEC = 5 * MiB;
constexpr size_t WS_W1 = 6 * MiB;
constexpr size_t WS_WD1 = 17 * MiB;
constexpr size_t WS_CUM = 6 * MiB;
constexpr size_t WS_WIN = 23 * MiB;
constexpr size_t WS_WOUT = 30 * MiB;
constexpr size_t WS_W2 = 32 * MiB;
constexpr size_t WS_WD2 = 43 * MiB;
constexpr size_t WS_WPG = 49 * MiB;
constexpr size_t WS_WPP = 51 * MiB;
constexpr size_t WS_PB = 52 * MiB;
constexpr size_t WS_HB = 60 * MiB;
constexpr size_t WS_BIG = 92 * MiB;
constexpr size_t WS_ST = 188 * MiB;
constexpr size_t WS_Y = 220 * MiB;
constexpr size_t WS_END = 252 * MiB;
static_assert(WS_WD1 + (size_t)D * FF * 2 <= WS_WIN && WS_CUM + 16 * MiB <= WS_WIN && WS_WIN + (size_t)NZG * D * 2 <= WS_WOUT && WS_WD2 + (size_t)D * FF * 2 <= WS_WPG, "weights map");
static_assert(WS_END <= 256 * MiB, "d_ws map");
constexpr int CW_BAR = 1024;
constexpr int RING_OFF = 0, RING_BYTES = 131072;
constexpr int LDSCTL_OFF = RING_BYTES, MISC_OFF = LDSCTL_OFF + 320;
constexpr int LDS_BYTES = 147456;
static_assert(MISC_OFF + 128 <= LDS_BYTES, "LDS map");

#define GAS __attribute__((address_space(1)))
#define LAS __attribute__((address_space(3)))
typedef unsigned short bf16;
typedef unsigned v4u __attribute__((ext_vector_type(4)));
typedef float f32x4 __attribute__((ext_vector_type(4)));
typedef GAS unsigned gu32;
#define RLX_AGENT __ATOMIC_RELAXED, __HIP_MEMORY_SCOPE_AGENT
#define LDS_WAIT() asm volatile("s_waitcnt lgkmcnt(0)" ::: "memory")
#define VM_WAIT() asm volatile("s_waitcnt vmcnt(0)" ::: "memory")
__device__ __forceinline__ unsigned pk2(float lo, float hi) { return pg8::cvt_pk_bf16(lo, hi); }

#define XB_TMO      128
#define XB_XCNT(j)  (256  + 64 * (j))
#define XB_XSUB(j)  (1280 + 64 * (j))
#define XB_XGEN(j)  (2304 + 64 * (j))
#define XB_TOP      3328
#define XB_TOPGEN   3392
#define XCD_BAR_WORDS 3456
#define XB_SPIN_CAP (1u << 18)
static_assert((CW_BAR + XCD_BAR_WORDS) * 4 <= (int)CTL_ZERO_BYTES, "barrier words inside the memset region");
__device__ __forceinline__ unsigned xb_ld(unsigned* p)              { return __hip_atomic_load(p, __ATOMIC_RELAXED, __HIP_MEMORY_SCOPE_AGENT); }
__device__ __forceinline__ unsigned xb_add(unsigned* p, unsigned v) { return __hip_atomic_fetch_add(p, v, __ATOMIC_RELAXED, __HIP_MEMORY_SCOPE_AGENT); }
__device__ __forceinline__ unsigned xb_xcc_id() { return (unsigned)__builtin_amdgcn_s_getreg((3 << 11) | 20) & 0xFu; }
#define XB_SPIN(cond, bar) do { unsigned _sp = 0; while (cond) { __builtin_amdgcn_s_sleep(1); \
    if ((++_sp & 255u) == 0u) { if (xb_ld(&(bar)[XB_TMO])) break; if (_sp > XB_SPIN_CAP) { atomicAdd(&(bar)[XB_TMO], 1u); break; } } } } while (0)
struct XcdBarrier { unsigned* bar; unsigned x; volatile LAS unsigned* st; int wave; };
__device__ __forceinline__ bool xb_thread0(int wave) { return wave == 0 && __builtin_amdgcn_mbcnt_hi(~0u, __builtin_amdgcn_mbcnt_lo(~0u, 0u)) == 0u; }
__device__ __forceinline__ XcdBarrier xcd_barrier_post(unsigned* bar, volatile LAS unsigned* st, int wave) {
    XcdBarrier b; b.bar = bar; b.x = xb_xcc_id(); b.st = st; b.wave = wave;
    if (xb_thread0(wave)) (void)xb_add(&bar[XB_XCNT(b.x)], 1u);
    return b;
}
__device__ __forceinline__ void xcd_barrier_complete(unsigned* bar, unsigned x, unsigned& nloc, unsigned& nx) {
    const unsigned G = gridDim.x * gridDim.y * gridDim.z;
    unsigned sum, cnt, mine, sp = 0u;
    for (;;) {
        sum = 0u; cnt = 0u; mine = 0u;
#pragma unroll
        for (unsigned j = 0; j < 16; ++j) { const unsigned c = xb_ld(&bar[XB_XCNT(j)]); sum += c; cnt += (c > 0u) ? 1u : 0u; mine = (j == x) ? c : mine; }
        if (sum == G) break;
        __builtin_amdgcn_s_sleep(1);
        if ((++sp & 255u) == 0u) { if (xb_ld(&bar[XB_TMO])) break; if (sp > XB_SPIN_CAP) { atomicAdd(&bar[XB_TMO], 1u); break; } }
    }
    nloc = mine > 0u ? mine : 1u; nx = cnt > 0u ? cnt : 1u;
}
__device__ __forceinline__ void xcd_barrier(const XcdBarrier& b) {
    asm volatile("s_waitcnt vmcnt(0)" ::: "memory");
    __syncthreads();
    if (xb_thread0(b.wave)) {
        unsigned* bar = b.bar;
        __builtin_amdgcn_s_waitcnt(0);
        unsigned nloc = b.st[0], nx = b.st[1];
        if (nloc == 0u) { xcd_barrier_complete(bar, b.x, nloc, nx); b.st[0] = nloc; b.st[1] = nx; }
        const unsigned old = xb_add(&bar[XB_XSUB(b.x)], 1u);
        const unsigned gen = old / nloc;
        if (old + 1u == (gen + 1u) * nloc) {
            __builtin_amdgcn_fence(__ATOMIC_RELEASE, "agent");
            asm volatile("s_waitcnt vmcnt(0)" ::: "memory");
            const unsigned og = xb_add(&bar[XB_TOP], 1u);
            const unsigned tg = og / nx;
            if (og + 1u == (tg + 1u) * nx) xb_add(&bar[XB_TOPGEN], 1u);
            else XB_SPIN(xb_ld(&bar[XB_TOPGEN]) == tg, bar);
            __builtin_amdgcn_fence(__ATOMIC_ACQUIRE, "agent");
            xb_add(&bar[XB_XGEN(b.x)], 1u);
            asm volatile("s_waitcnt vmcnt(0)" ::: "memory");
        } else {
            XB_SPIN(xb_ld(&bar[XB_XGEN(b.x)]) == gen, bar);
            __builtin_amdgcn_fence(__ATOMIC_ACQUIRE, "agent");
            asm volatile("s_waitcnt vmcnt(0)" ::: "memory");
        }
    }
    __syncthreads();
}

__device__ __forceinline__ float wave_sum(float v) {
#pragma unroll
    for (int o = 1; o < 64; o <<= 1) v += __shfl_xor(v, o);
    return v;
}
__device__ __forceinline__ void p0_item(const float* W, int K, int N, const float* gain, bf16* WT, int k0, int c0, int nvalid, int dst0, LAS float* scr, int lane) {
    const int r8 = lane >> 3, cc = (lane & 7) * 4;
    f32x4 v[8]; float gn[8];
    const float* wp = W + (size_t)(k0 + r8) * N + c0 + cc;
#pragma unroll
    for (int i = 0; i < 8; ++i) { v[i] = (cc < nvalid) ? *(const f32x4*)(wp + (size_t)(8 * i) * N) : (f32x4){0.f, 0.f, 0.f, 0.f}; gn[i] = gain ? gain[k0 + 8 * i + r8] : 1.0f; }
#pragma unroll
    for (int i = 0; i < 8; ++i) { LAS float* d = scr + (8 * i + r8) * 33 + cc; d[0] = v[i].x * gn[i]; d[1] = v[i].y * gn[i]; d[2] = v[i].z * gn[i]; d[3] = v[i].w * gn[i]; }
    LDS_WAIT(); asm volatile("" ::: "memory");
    const int c = lane & 7;
#pragma unroll
    for (int j = 0; j < 4; ++j) { const int n = (lane >> 3) + 8 * j; const LAS float* s = scr + (8 * c) * 33 + n;
        v4u o; o.x = pk2(s[0 * 33], s[1 * 33]); o.y = pk2(s[2 * 33], s[3 * 33]); o.z = pk2(s[4 * 33], s[5 * 33]); o.w = pk2(s[6 * 33], s[7 * 33]);
        *(GAS v4u*)(WT + (size_t)(dst0 + n) * K + k0 + 8 * c) = o; }
    LDS_WAIT(); asm volatile("" ::: "memory");
}
__device__ __forceinline__ void win_group(int dst0, int& c0, int& nvalid) {
    nvalid = 32;
    if (dst0 < 1536) { c0 = dst0; return; }
    if (dst0 < 2048) {
        const int seg = (dst0 - 1536) >> 8, p = (dst0 - 1536) & 255, bj = p >> 7, hd = (p >> 5) & 3;
        c0 = 1552 + seg * 256 + hd * 64 + bj * 32; return; }
    if (dst0 < 3072) { c0 = dst0 + 16; return; }
    if (dst0 == 3072) { c0 = 1536; nvalid = 16; return; }
    c0 = 0; nvalid = 0;
}

struct KArgs { const float* in[21]; float* out; unsigned char* ws; };

__global__ void __launch_bounds__(NWAVES * 64, 2) hymba_fwd(KArgs args) {
    extern __shared__ __attribute__((aligned(16))) unsigned char lds_raw[];
    LAS unsigned char* lds = (LAS unsigned char*)lds_raw;
    volatile LAS unsigned* MISC = (volatile LAS unsigned*)(lds + MISC_OFF);
    const int wave = __builtin_amdgcn_readfirstlane((int)threadIdx.x >> 6);
#define PHASE_TID() int lane = (int)__builtin_amdgcn_mbcnt_hi(~0u, __builtin_amdgcn_mbcnt_lo(~0u, 0u)); asm volatile("" : "+v"(lane)); const int tid = wave * 64 + lane; (void)tid
    const int G = gridDim.x; const int bx = blockIdx.x; const int vcu = (G % 8 == 0) ? (bx % 8) * (G / 8) + bx / 8 : bx;
    unsigned char* ws = args.ws;
    const float* x = args.in[0]; const float* pin = args.in[1]; const float* g_ffn1 = args.in[2]; const float* w1g = args.in[3]; const float* w1u = args.in[4]; const float* w1d = args.in[5];
    const float* g_mix = args.in[6]; const float* w_in = args.in[7]; const float* wgu = args.in[8]; const float* bgate = args.in[9]; const float* g_gla = args.in[10]; const float* g_ret = args.in[11];
    const float* w_out = args.in[12]; const float* g_ffn2 = args.in[13]; const float* w2g = args.in[14]; const float* w2u = args.in[15]; const float* w2d = args.in[16];
    const float* g_ple = args.in[17]; const float* w_pg = args.in[18]; const float* w_pp = args.in[19]; const float* g_final = args.in[20];
    float* out = args.out;
    gu32* ctl = (gu32*)(ws + WS_CTL);
    float* PARTA = (float*)(ws + WS_PARTA); float* PARTB = (float*)(ws + WS_PARTB); float* GLR = (float*)(ws + WS_GLR);
    float* COS = (float*)(ws + WS_COS); float* SIN = (float*)(ws + WS_SIN); float* DEC = (float*)(ws + WS_DEC); float* CUM = (float*)(ws + WS_CUM);
    bf16* W1T = (bf16*)(ws + WS_W1); bf16* WD1T = (bf16*)(ws + WS_WD1); bf16* WINT = (bf16*)(ws + WS_WIN); bf16* WOUTT = (bf16*)(ws + WS_WOUT);
    bf16* W2T = (bf16*)(ws + WS_W2); bf16* WD2T = (bf16*)(ws + WS_WD2); bf16* WPGT = (bf16*)(ws + WS_WPG); bf16* WPPT = (bf16*)(ws + WS_WPP);
    bf16* PB = (bf16*)(ws + WS_PB); bf16* HB = (bf16*)(ws + WS_HB); bf16* BIG = (bf16*)(ws + WS_BIG); bf16* ST = (bf16*)(ws + WS_ST); bf16* Y = (bf16*)(ws + WS_Y);

    for (int u = threadIdx.x; u < (LDS_BYTES - LDSCTL_OFF) / 4; u += NWAVES * 64) ((LAS unsigned*)(lds + LDSCTL_OFF))[u] = 0u;
    __syncthreads();
    XcdBarrier bar = xcd_barrier_post((unsigned*)(ctl + CW_BAR), MISC + 8, wave);
#define GRID_BAR() xcd_barrier(bar)
    const int gw = vcu * NWAVES + wave, NGW = G * NWAVES;

    REPS(1) if (PHMASK & 1) { REP_BAR(1);
        PHASE_TID();
        LAS float* scr = (LAS float*)(lds + RING_OFF + wave * 16384);
        constexpr int I_GU = (D / 64) * (FF / 32), I_DN = (FF / 64) * (D / 32), I_IN = (D / 64) * (NZG / 32), I_SQ = (D / 64) * (D / 32), I_PP = (PLE / 64) * (D / 32);
        constexpr int NITEMS = 4 * I_GU + 2 * I_DN + I_IN + 2 * I_SQ + I_PP;
        for (int it = gw; it < NITEMS; it += NGW) {
            int r = it;
            if (r < 4 * I_GU) {
                const int which = r / I_GU; r -= which * I_GU; const int kb = r / (FF / 32), nb = r % (FF / 32), j0 = nb * 32;
                const float* W = which == 0 ? w1g : which == 1 ? w1u : which == 2 ? w2g : w2u; const float* gain = which < 2 ? g_ffn1 : g_ffn2; bf16* WT = which < 2 ? W1T : W2T;
                p0_item(W, D, FF, gain, WT, kb * 64, j0, 32, 256 * (j0 >> 7) + 128 * (which & 1) + (j0 & 127), scr, lane); continue; }
            r -= 4 * I_GU;
            if (r < 2 * I_DN) { const int which = r / I_DN; r -= which * I_DN; const int kb = r / (D / 32), nb = r % (D / 32);
                p0_item(which == 0 ? w1d : w2d, FF, D, nullptr, which == 0 ? WD1T : WD2T, kb * 64, nb * 32, 32, nb * 32, scr, lane); continue; }
            r -= 2 * I_DN;
            if (r < I_IN) { const int kb = r / (NZG / 32), nb = r % (NZG / 32); int c0, nv; win_group(nb * 32, c0, nv);
                p0_item(w_in, D, IN_COLS, g_mix, WINT, kb * 64, c0, nv, nb * 32, scr, lane); continue; }
            r -= I_IN;
            if (r < 2 * I_SQ) { const int which = r / I_SQ; r -= which * I_SQ; const int kb = r / (D / 32), nb = r % (D / 32);
                p0_item(which == 0 ? w_out : w_pg, D, D, which == 0 ? nullptr : g_ple, which == 0 ? WOUTT : WPGT, kb * 64, nb * 32, 32, nb * 32, scr, lane); continue; }
            r -= 2 * I_SQ;
            { const int kb = r / (D / 32), nb = r % (D / 32); p0_item(w_pp, PLE, D, nullptr, WPPT, kb * 64, nb * 32, 32, nb * 32, scr, lane); }
        }
        for (int m = gw * 2; m < M; m += NGW * 2) {
            f32x4 v[2][4]; float s[2];
#pragma unroll
            for (int q = 0; q < 2; ++q) { const GAS f32x4* xr = (const GAS f32x4*)(x + (size_t)(m + q) * D) + lane;
#pragma unroll
                for (int j = 0; j < 4; ++j) v[q][j] = xr[64 * j]; }
#pragma unroll
            for (int q = 0; q < 2; ++q) { float a = 0.f;
#pragma unroll
                for (int j = 0; j < 4; ++j) a += (v[q][j].x * v[q][j].x + v[q][j].y * v[q][j].y) + (v[q][j].z * v[q][j].z + v[q][j].w * v[q][j].w);
                s[q] = wave_sum(a);
                GAS unsigned long long* o8 = (GAS unsigned long long*)(HB + (size_t)(m + q) * D) + lane;
#pragma unroll
                for (int j = 0; j < 4; ++j) o8[64 * j] = (unsigned long long)pk2(v[q][j].x, v[q][j].y) | ((unsigned long long)pk2(v[q][j].z, v[q][j].w) << 32);
                if (lane < 16) PARTA[(size_t)(m + q) * 16 + lane] = lane == 0 ? s[q] : 0.f; }
        }
        for (int m = gw * 4; m < M; m += NGW * 4) { f32x4 v[4];
#pragma unroll
            for (int q = 0; q < 4; ++q) v[q] = *((const GAS f32x4*)(pin + (size_t)(m + q) * PLE) + lane);
#pragma unroll
            for (int q = 0; q < 4; ++q) *((GAS unsigned long long*)(PB + (size_t)(m + q) * PLE) + lane) = (unsigned long long)pk2(v[q].x, v[q].y) | ((unsigned long long)pk2(v[q].z, v[q].w) << 32); }
        for (int e = bx * (NWAVES * 64) + tid; e < SEQ * 32; e += G * NWAVES * 64) { const int pos = e >> 5, i = e & 31;
            const float inv = powf(10000.0f, -(float)i / 32.0f); const float ang = (float)pos * inv; COS[e] = cosf(ang); SIN[e] = sinf(ang); }
    }
    GRID_BAR();

    REPS(2) if (PHMASK & 2) { REP_BAR(2); pg8::Gemm g{HB, W1T, M, 2 * FF, D}; pg8::StaticOrder S; S.init(M, 2 * FF, G, bx);
      pg8::EpiSwiGLU E{BIG, FF, PARTA};
      pg8::gemm_phase<pg8::EpiSwiGLU, pg8::StaticOrder, true, true>(lds + RING_OFF, g, S, E, wave); }
    GRID_BAR();
    REPS(4) if (PHMASK & 4) { REP_BAR(4); pg8::Gemm g{BIG, WD1T, M, D, FF}; pg8::StaticOrder S; S.init(M, D, G, bx);
      pg8::EpiResid E{x, out, HB, PARTB, 0.5f, D};
      pg8::gemm_phase<pg8::EpiResid, pg8::StaticOrder, true, true>(lds + RING_OFF, g, S, E, wave); }
    GRID_BAR();
    REPS(8) if (PHMASK & 8) { REP_BAR(8); pg8::Gemm g{HB, WINT, M, NZ, D}; pg8::StaticOrder S; S.init(M, NZ, G, bx);
      pg8::EpiZ E{BIG, GLR, PARTB, COS, SIN};
      pg8::gemm_phase<pg8::EpiZ, pg8::StaticOrder, true, true>(lds + RING_OFF, g, S, E, wave);
      { PHASE_TID();
        typedef short bf16x8_t __attribute__((ext_vector_type(8)));
        const int kh = wave >> 2, fr = lane & 15, fq = lane >> 4;
        LAS f32x4* red = (LAS f32x4*)(lds + RING_OFF) + (wave & 3) * 64 + lane;
        for (int t0 = vcu * 4; t0 < M / 16; t0 += G * 4) { const int t = t0 + (wave & 3);
            const bf16* ap = HB + (size_t)(t * 16 + fr) * D + kh * 512 + 8 * fq; const bf16* bp = WINT + (size_t)(3072 + fr) * D + kh * 512 + 8 * fq;
            f32x4 acc = {0.f, 0.f, 0.f, 0.f};
#pragma unroll
            for (int ks = 0; ks < 16; ++ks) { const bf16x8_t a = *(const bf16x8_t*)(ap + 32 * ks), b = *(const bf16x8_t*)(bp + 32 * ks); acc = __builtin_amdgcn_mfma_f32_16x16x32_bf16(a, b, acc, 0, 0, 0); }
            if (kh == 1) *red = acc;
            LDS_WAIT(); __syncthreads();
            if (kh == 0) { const f32x4 o = *red;
#pragma unroll
                for (int r = 0; r < 4; ++r) { const int row = t * 16 + 4 * fq + r; GLR[(size_t)row * 16 + fr] = (acc[r] + o[r]) * pg8::rstd_from_part(PARTB, row); } }
            __syncthreads();
        } } }
    GRID_BAR();
    const mix::MixPtrs MP{BIG, GLR, ST, DEC, CUM, Y, wgu, bgate, g_gla, g_ret};
    REPS(16) if (PHMASK & 16) { REP_BAR(16);
        PHASE_TID();
        const mix::ldsp wl = lds + RING_OFF + wave * 16384;
        const int kind = wave >> 2;
        for (int u = vcu * 4 + (wave & 3); u < 1024; u += G * 4) { if (kind == 0) mix::m1_unit<0>(MP, u, wl, lane); else mix::m1_unit<1>(MP, u, wl, lane); }
    }
    GRID_BAR();
    if (PHMASK & 32) { PHASE_TID(); mix::m2_scan(MP, bx * (NWAVES * 64) + tid, G * NWAVES * 64); }
    GRID_BAR();
    REPS(64) if (PHMASK & 64) { REP_BAR(64);
        PHASE_TID();
        const mix::ldsp wl = lds + RING_OFF + wave * 16384;
        const int kind = wave >> 2;
        for (int u = vcu * 4 + (wave & 3); u < 1024; u += G * 4) { if (kind == 0) mix::m3_unit<0>(MP, u, wl, lane); else mix::m3_unit<1>(MP, u, wl, lane); }
    }
    GRID_BAR();
    if (PHMASK & 128) { pg8::Gemm g{Y, WOUTT, M, D, D}; pg8::StaticOrder S; S.init(M, D, G, bx);
      pg8::EpiResid E{out, out, HB, PARTA, 1.0f, D};
      pg8::gemm_phase<pg8::EpiResid, pg8::StaticOrder, true, true>(lds + RING_OFF, g, S, E, wave); }
    GRID_BAR();
    REPS(256) if (PHMASK & 256) { REP_BAR(256); pg8::Gemm g{HB, W2T, M, 2 * FF, D}; pg8::StaticOrder S; S.init(M, 2 * FF, G, bx);
      pg8::EpiSwiGLU E{BIG, FF, PARTA};
      pg8::gemm_phase<pg8::EpiSwiGLU, pg8::StaticOrder, true, true>(lds + RING_OFF, g, S, E, wave); }
    GRID_BAR();
    if (PHMASK & 512) { pg8::Gemm g{BIG, WD2T, M, D, FF}; pg8::StaticOrder S; S.init(M, D, G, bx);
      pg8::EpiResid E{out, out, HB, PARTB, 0.5f, D};
      pg8::gemm_phase<pg8::EpiResid, pg8::StaticOrder, true, true>(lds + RING_OFF, g, S, E, wave); }
    if (PHMASK & 1024) { pg8::Gemm g{PB, WPPT, M, D, PLE}; pg8::StaticOrder S; S.init(M, D, G, bx);
      pg8::EpiPlainBf16 E{ST, D};
      pg8::gemm_phase<pg8::EpiPlainBf16, pg8::StaticOrder, true, true>(lds + RING_OFF, g, S, E, wave); }
    GRID_BAR();
    if (PHMASK & 2048) { pg8::Gemm g{HB, WPGT, M, D, D}; pg8::StaticOrder S; S.init(M, D, G, bx);
      pg8::EpiPle E{out, out, ST, PARTB, PARTA, D};
      pg8::gemm_phase<pg8::EpiPle, pg8::StaticOrder, true, true>(lds + RING_OFF, g, S, E, wave); }
    GRID_BAR();
    if (PHMASK & 4096) {
        PHASE_TID();
        const bool bad = xb_ld((unsigned*)(ctl + CW_BAR) + XB_TMO) != 0u; const float qn = __builtin_nanf("");
        for (int m = gw; m < M; m += NGW) {
            const float rs = pg8::rstd_from_part(PARTA, m);
            GAS f32x4* orow = (GAS f32x4*)(out + (size_t)m * D) + lane; const GAS f32x4* gf = (const GAS f32x4*)g_final + lane;
#pragma unroll
            for (int j = 0; j < 4; ++j) { f32x4 v = orow[64 * j] * rs * gf[64 * j]; if (bad) v = (f32x4){qn, qn, qn, qn}; orow[64 * j] = v; }
        }
    }
}

extern "C" void kernel_launch(void* const* d_in, const int* in_sizes, int n_in, void* d_out, int out_size, void* d_ws, size_t ws_size, hipStream_t stream) {
    static int grid = 0;
    if (grid == 0) {
        if (n_in != 21 || in_sizes[0] != M * D || out_size != M * D || ws_size < WS_END) { fprintf(stderr, "kernel_launch: unexpected shapes (n_in %d, in0 %d, out %d, ws %zu); nothing launched\n", n_in, n_in > 0 ? in_sizes[0] : -1, out_size, ws_size); grid = -1; return; }
        int dev = 0, cus = 0, per_cu = 0;
        if (hipGetDevice(&dev) != hipSuccess || hipDeviceGetAttribute(&cus, hipDeviceAttributeMultiprocessorCount, dev) != hipSuccess) { fprintf(stderr, "kernel_launch: device query failed\n"); grid = -1; return; }
        if (hipFuncSetAttribute((const void*)hymba_fwd, hipFuncAttributeMaxDynamicSharedMemorySize, LDS_BYTES) != hipSuccess) { fprintf(stderr, "kernel_launch: hipFuncSetAttribute failed\n"); grid = -1; return; }
        if (hipOccupancyMaxActiveBlocksPerMultiprocessor(&per_cu, (const void*)hymba_fwd, NWAVES * 64, LDS_BYTES) != hipSuccess || per_cu < 1) { fprintf(stderr, "kernel_launch: occupancy query says %d blocks per CU\n", per_cu); per_cu = 1; }
        (void)hipGetLastError();
        grid = cus;
    }
    if (grid < 0) return;
    if (hipMemsetAsync((char*)d_ws + WS_CTL, 0, CTL_ZERO_BYTES, stream) != hipSuccess) { fprintf(stderr, "kernel_launch: memset failed\n"); return; }
    KArgs a{};
    for (int i = 0; i < 21; ++i) a.in[i] = (const float*)d_in[i];
    a.out = (float*)d_out; a.ws = (unsigned char*)d_ws;
    hipLaunchKernelGGL(hymba_fwd, dim3(grid), dim3(NWAVES * 64), LDS_BYTES, stream, a);
    const hipError_t le = hipPeekAtLastError();
    if (le != hipSuccess) fprintf(stderr, "kernel_launch: launch failed: %s\n", hipGetErrorName(le));
}
```
